# Optimizing an MI355X kernel written in HIP

```python
import jax, jax.numpy as jnp
from jax import lax
import numpy as np

D_MODEL = 1024
BATCH = 2
SEQ = 8192
DEPTH = 1

CONV_CH = D_MODEL // 2
CONV_K = 3
N_HEADS = 8
HEAD_DIM = (D_MODEL // 2) // N_HEADS
N_KV_HEADS = 2
GQA = N_HEADS // N_KV_HEADS
N_BRANCH = 3
CMP_BLOCK = 32
CMP_STRIDE = 16
CMP_HIDDEN = 256
SEL_BLOCK = 64
SEL_TOP = 16
WINDOW = 512
Q_BLOCK = 128
D_FF = ((8 * D_MODEL // 3 + 255) // 256) * 256
NORM_EPS = 1e-6

kernel_name = "hymba_conv_nsa_alibi_block"


def _proj_sizes():
    kv = N_KV_HEADS * HEAD_DIM
    return [CONV_CH, CONV_CH, CONV_CH, N_HEADS * HEAD_DIM, kv, kv, kv, kv, kv, kv, N_HEADS * N_BRANCH]


def _split_points():
    return [int(v) for v in np.cumsum(_proj_sizes())[:-1]]


def _rmsnorm(x, g):
    xf = x.astype(jnp.float32)
    y = xf * lax.rsqrt(jnp.mean(xf * xf, axis=-1, keepdims=True) + NORM_EPS)
    return (y * g.astype(jnp.float32)).astype(x.dtype)


def _masked_softmax(s, mask):
    s = jnp.where(mask, s, -jnp.inf)
    m = jnp.max(s, axis=-1, keepdims=True)
    m = jnp.where(jnp.isfinite(m), m, 0.0)
    e = jnp.where(mask, jnp.exp(s - m), 0.0)
    return e / jnp.maximum(jnp.sum(e, axis=-1, keepdims=True), 1e-30)


def _alibi_slopes():
    h = jnp.arange(1, N_HEADS + 1, dtype=jnp.float32)
    return jnp.exp2(-8.0 * h / N_HEADS)


def _short_conv(b_gate, c_gate, h, conv_w):
    u = c_gate * h
    up = jnp.pad(u, ((0, 0), (CONV_K - 1, 0), (0, 0)))
    S = u.shape[1]
    conv = sum(conv_w[i] * up[:, i:i + S] for i in range(CONV_K))
    return b_gate * conv


def _compress(k, pos, w1, w2):
    B, S = k.shape[:2]
    nc = (S - CMP_BLOCK) // CMP_STRIDE + 1
    idx = CMP_STRIDE * jnp.arange(nc)[:, None] + jnp.arange(CMP_BLOCK)[None, :]
    blk = k[:, idx] + pos[None, None, :, None, :]
    blk = blk.transpose(0, 1, 3, 2, 4).reshape(B, nc, N_KV_HEADS, CMP_BLOCK * HEAD_DIM)
    return jax.nn.gelu(blk @ w1) @ w2


def _nsa(q, k_cmp, v_cmp, k_sel, v_sel, k_win, v_win, gates,
         k_cmp_pos, k_cmp_w1, k_cmp_w2, v_cmp_pos, v_cmp_w1, v_cmp_w2):
    B, S = q.shape[:2]
    f32 = jnp.float32
    scale = HEAD_DIM ** -0.5
    slopes = _alibi_slopes().reshape(N_KV_HEADS, GQA)[None, :, :, None, None]

    kc = _compress(k_cmp, k_cmp_pos, k_cmp_w1, k_cmp_w2)
    vc = _compress(v_cmp, v_cmp_pos, v_cmp_w1, v_cmp_w2)
    nc = kc.shape[1]
    c_start = CMP_STRIDE * jnp.arange(nc)
    c_end = c_start + CMP_BLOCK - 1

    n_sel = S // SEL_BLOCK
    n_top = min(SEL_TOP, n_sel)
    s_start = SEL_BLOCK * jnp.arange(n_sel)
    ov = jnp.minimum(c_end[:, None] + 1, s_start[None, :] + SEL_BLOCK) - jnp.maximum(c_start[:, None], s_start[None, :])
    overlap = jnp.clip(ov, 0).astype(f32) / CMP_BLOCK
    ks_blk = k_sel.reshape(B, n_sel, SEL_BLOCK, N_KV_HEADS, HEAD_DIM).transpose(0, 3, 1, 2, 4)
    vs_blk = v_sel.reshape(B, n_sel, SEL_BLOCK, N_KV_HEADS, HEAD_DIM).transpose(0, 3, 1, 2, 4)
    bi = jnp.arange(B)[:, None, None, None]
    ki = jnp.arange(N_KV_HEADS)[None, :, None, None]

    kw_pad = jnp.pad(k_win, ((0, 0), (WINDOW, 0), (0, 0), (0, 0)))
    vw_pad = jnp.pad(v_win, ((0, 0), (WINDOW, 0), (0, 0), (0, 0)))

    nq = S // Q_BLOCK
    qb = q.reshape(B, nq, Q_BLOCK, N_KV_HEADS, GQA, HEAD_DIM).transpose(1, 0, 2, 3, 4, 5)
    gb = gates.reshape(B, nq, Q_BLOCK, N_KV_HEADS, GQA, N_BRANCH).transpose(1, 0, 2, 3, 4, 5)
    starts = jnp.arange(nq, dtype=jnp.int32) * Q_BLOCK

    def block(args):
        qi, gi, q0 = args
        t = q0 + jnp.arange(Q_BLOCK, dtype=jnp.int32)

        dist_c = (t[:, None] - c_end[None, :]).astype(f32)
        s_c = jnp.einsum('bqkgd,bnkd->bkgqn', qi, kc).astype(f32) * scale - slopes * dist_c
        p_c = _masked_softmax(s_c, dist_c >= 0)
        o_c = jnp.einsum('bkgqn,bnkd->bqkgd', p_c.astype(vc.dtype), vc)

        imp = jnp.einsum('bkgqn,nj->bkqj', p_c, overlap)
        jblk = jnp.arange(n_sel)[None, :]
        imp = jnp.where(s_start[None, :] > t[:, None], -jnp.inf, imp)
        forced = (jblk == 0) | (jblk == (t[:, None] // SEL_BLOCK))
        imp = jnp.where(forced, jnp.inf, imp)
        _, idx = lax.top_k(imp, n_top)
        k_g = ks_blk[bi, ki, idx].reshape(B, N_KV_HEADS, Q_BLOCK, n_top * SEL_BLOCK, HEAD_DIM)
        v_g = vs_blk[bi, ki, idx].reshape(B, N_KV_HEADS, Q_BLOCK, n_top * SEL_BLOCK, HEAD_DIM)
        pos = (idx[..., None] * SEL_BLOCK + jnp.arange(SEL_BLOCK)).reshape(B, N_KV_HEADS, Q_BLOCK, n_top * SEL_BLOCK)
        dist_s = (t[None, None, :, None] - pos).astype(f32)[:, :, None]
        s_s = jnp.einsum('bqkgd,bkqmd->bkgqm', qi, k_g).astype(f32) * scale - slopes * dist_s
        p_s = _masked_softmax(s_s, dist_s >= 0)
        o_s = jnp.einsum('bkgqm,bkqmd->bqkgd', p_s.astype(v_g.dtype), v_g)

        kwi = lax.dynamic_slice_in_dim(kw_pad, q0, Q_BLOCK + WINDOW, axis=1)
        vwi = lax.dynamic_slice_in_dim(vw_pad, q0, Q_BLOCK + WINDOW, axis=1)
        kpos = q0 - WINDOW + jnp.arange(Q_BLOCK + WINDOW, dtype=jnp.int32)
        dist_w = t[:, None] - kpos[None, :]
        mask_w = (dist_w >= 0) & (dist_w < WINDOW) & (kpos[None, :] >= 0)
        s_w = jnp.einsum('bqkgd,bskd->bkgqs', qi, kwi).astype(f32) * scale - slopes * dist_w.astype(f32)
        p_w = _masked_softmax(s_w, mask_w)
        o_w = jnp.einsum('bkgqs,bskd->bqkgd', p_w.astype(vwi.dtype), vwi)

        return gi[..., 0:1] * o_c + gi[..., 1:2] * o_s + gi[..., 2:3] * o_w

    out = lax.map(block, (qb, gb, starts))
    return out.transpose(1, 0, 2, 3, 4, 5).reshape(B, S, N_HEADS * HEAD_DIM)


def setup_inputs(seed: int = 0) -> dict:
    key = jax.random.key(seed)
    ks = jax.random.split(key, 20)
    nrm = jax.random.normal
    d_in = sum(_proj_sizes())
    f = jnp.float32
    return {
        "x": nrm(ks[0], (BATCH, SEQ, D_MODEL), f),
        "norm1_g": 1.0 + 0.1 * nrm(ks[1], (DEPTH, D_MODEL), f),
        "w_in": nrm(ks[2], (DEPTH, D_MODEL, d_in), f) * D_MODEL ** -0.5,
        "conv_w": nrm(ks[3], (DEPTH, CONV_K, CONV_CH), f) * CONV_K ** -0.5,
        "k_cmp_pos": 0.1 * nrm(ks[4], (DEPTH, CMP_BLOCK, HEAD_DIM), f),
        "k_cmp_w1": nrm(ks[5], (DEPTH, CMP_BLOCK * HEAD_DIM, CMP_HIDDEN), f) * (CMP_BLOCK * HEAD_DIM) ** -0.5,
        "k_cmp_w2": nrm(ks[6], (DEPTH, CMP_HIDDEN, HEAD_DIM), f) * CMP_HIDDEN ** -0.5,
        "v_cmp_pos": 0.1 * nrm(ks[7], (DEPTH, CMP_BLOCK, HEAD_DIM), f),
        "v_cmp_w1": nrm(ks[8], (DEPTH, CMP_BLOCK * HEAD_DIM, CMP_HIDDEN), f) * (CMP_BLOCK * HEAD_DIM) ** -0.5,
        "v_cmp_w2": nrm(ks[9], (DEPTH, CMP_HIDDEN, HEAD_DIM), f) * CMP_HIDDEN ** -0.5,
        "gn_conv_g": 1.0 + 0.1 * nrm(ks[10], (DEPTH, CONV_CH), f),
        "gn_nsa_g": 1.0 + 0.1 * nrm(ks[11], (DEPTH, N_HEADS * HEAD_DIM), f),
        "w_out": nrm(ks[12], (DEPTH, CONV_CH + N_HEADS * HEAD_DIM, D_MODEL), f) * (CONV_CH + N_HEADS * HEAD_DIM) ** -0.5,
        "norm2_g": 1.0 + 0.1 * nrm(ks[13], (DEPTH, D_MODEL), f),
        "w_gate": nrm(ks[14], (DEPTH, D_MODEL, D_FF), f) * D_MODEL ** -0.5,
        "w_up": nrm(ks[15], (DEPTH, D_MODEL, D_FF), f) * D_MODEL ** -0.5,
        "w_down": nrm(ks[16], (DEPTH, D_FF, D_MODEL), f) * D_FF ** -0.5,
        "norm_f_g": 1.0 + 0.1 * nrm(ks[17], (D_MODEL,), f),
    }


def reference(x, norm1_g, w_in, conv_w, k_cmp_pos, k_cmp_w1, k_cmp_w2, v_cmp_pos, v_cmp_w1, v_cmp_w2,
              gn_conv_g, gn_nsa_g, w_out, norm2_g, w_gate, w_up, w_down, norm_f_g):
    h = x
    B, S, _ = x.shape
    for l in range(DEPTH):
        u = _rmsnorm(h, norm1_g[l])
        proj = u @ w_in[l]
        cb, cc, ch, q, kc, vc, ksl, vsl, kw, vw, g = jnp.split(proj, _split_points(), axis=-1)

        conv_out = _short_conv(cb, cc, ch, conv_w[l])

        kvs = lambda t_: t_.reshape(B, S, N_KV_HEADS, HEAD_DIM)
        qh = q.reshape(B, S, N_KV_HEADS, GQA, HEAD_DIM)
        gates = jax.nn.sigmoid(g.reshape(B, S, N_KV_HEADS, GQA, N_BRANCH))
        nsa_out = _nsa(qh, kvs(kc), kvs(vc), kvs(ksl), kvs(vsl), kvs(kw), kvs(vw), gates,
                       k_cmp_pos[l], k_cmp_w1[l], k_cmp_w2[l], v_cmp_pos[l], v_cmp_w1[l], v_cmp_w2[l])

        mixed = jnp.concatenate([_rmsnorm(conv_out, gn_conv_g[l]), _rmsnorm(nsa_out, gn_nsa_g[l])], axis=-1)
        h = h + mixed @ w_out[l]

        u2 = _rmsnorm(h, norm2_g[l])
        h = h + (jax.nn.silu(u2 @ w_gate[l]) * (u2 @ w_up[l])) @ w_down[l]
    return _rmsnorm(h, norm_f_g)
```

```cpp
#include <hip/hip_runtime.h>
#include <cstdio>
#include <cstdint>

namespace nv {
constexpr int B = 2, S = 8192, M = B * S, D = 1024, DIN = 2840, CC = 512, NH = 8, HD = 64, NKV = 2, GQ = 4;
constexpr int NC = 511, NSEL = 128, NTOP = 16, WIN = 512, DFF = 2816, CH = 256, CMPK = 2048;
constexpr int C_CB = 0, C_CC = 512, C_CH = 1024, C_Q = 1536, C_KC = 2048, C_VC = 2176, C_KS = 2304, C_VS = 2432, C_KW = 2560, C_VW = 2688, C_G = 2816;
constexpr float EPS = 1e-6f;

__device__ __forceinline__ float wave_sum(float v) {
#pragma unroll
    for (int o = 1; o < 64; o <<= 1) v += __shfl_xor(v, o);
    return v;
}
__device__ __forceinline__ float wave_max(float v) {
#pragma unroll
    for (int o = 1; o < 64; o <<= 1) v = fmaxf(v, __shfl_xor(v, o));
    return v;
}

__global__ void rmsnorm_k(const float* in, int ldi, const float* g, float* out, int ldo, int rows, int ncols) {
    const int w = (blockIdx.x * blockDim.x + threadIdx.x) >> 6, lane = threadIdx.x & 63;
    if (w >= rows) return;
    const float* x = in + (size_t)w * ldi;
    float s = 0.f;
    for (int c = lane; c < ncols; c += 64) { const float v = x[c]; s += v * v; }
    s = wave_sum(s);
    const float r = 1.0f / sqrtf(s / (float)ncols + EPS);
    float* o = out + (size_t)w * ldo;
    for (int c = lane; c < ncols; c += 64) o[c] = x[c] * r * g[c];
}

template <int EPI>
__global__ void __launch_bounds__(256) gemm_f32(const float* A, int lda, const float* Bm, int ldb, float* C, int ldc, const float* R, int ldr, int Mr, int N, int K) {
    __shared__ float As[16][68];
    __shared__ float Bs[16][68];
    const int tid = threadIdx.x, tx = tid & 15, ty = tid >> 4;
    const int m0 = blockIdx.y * 64, n0 = blockIdx.x * 64;
    float acc[4][4];
#pragma unroll
    for (int i = 0; i < 4; ++i)
#pragma unroll
        for (int j = 0; j < 4; ++j) acc[i][j] = 0.f;
    const int ar = tid >> 2, ak = (tid & 3) * 4;
    const int bk = tid >> 4, bc = (tid & 15) * 4;
    for (int k0 = 0; k0 < K; k0 += 16) {
        float4 av = make_float4(0.f, 0.f, 0.f, 0.f), bv = make_float4(0.f, 0.f, 0.f, 0.f);
        if (m0 + ar < Mr) av = *(const float4*)(A + (size_t)(m0 + ar) * lda + k0 + ak);
        if (n0 + bc < N) bv = *(const float4*)(Bm + (size_t)(k0 + bk) * ldb + n0 + bc);
        __syncthreads();
        As[ak + 0][ar] = av.x; As[ak + 1][ar] = av.y; As[ak + 2][ar] = av.z; As[ak + 3][ar] = av.w;
        *(float4*)&Bs[bk][bc] = bv;
        __syncthreads();
#pragma unroll
        for (int k = 0; k < 16; ++k) {
            const float4 a = *(const float4*)&As[k][ty * 4];
            const float4 b = *(const float4*)&Bs[k][tx * 4];
            const float aa[4] = {a.x, a.y, a.z, a.w}, bb[4] = {b.x, b.y, b.z, b.w};
#pragma unroll
            for (int i = 0; i < 4; ++i)
#pragma unroll
                for (int j = 0; j < 4; ++j) acc[i][j] = fmaf(aa[i], bb[j], acc[i][j]);
        }
    }
#pragma unroll
    for (int i = 0; i < 4; ++i) {
        const int r = m0 + ty * 4 + i;
        if (r >= Mr) continue;
#pragma unroll
        for (int j = 0; j < 4; ++j) {
            const int c = n0 + tx * 4 + j;
            if (c >= N) continue;
            float v = acc[i][j];
            if (EPI == 1) v += R[(size_t)r * ldr + c];
            if (EPI == 2) { const float gte = C[(size_t)r * ldc + c]; v = (gte / (1.0f + expf(-gte))) * v; }
            C[(size_t)r * ldc + c] = v;
        }
    }
}

__global__ void conv_k(const float* proj, const float* cw, float* out, int ldo) {
    const size_t idx = (size_t)blockIdx.x * blockDim.x + threadIdx.x;
    if (idx >= (size_t)M * CC) return;
    const int c = (int)(idx % CC); const int m = (int)(idx / CC); const int t = m % S;
    const float* p = proj + (size_t)m * DIN;
    float acc = 0.f;
#pragma unroll
    for (int i = 0; i < 3; ++i) { const int tt = t - 2 + i; if (tt >= 0) { const float* q = p + (ptrdiff_t)(i - 2) * DIN; acc += cw[i * CC + c] * (q[C_CC + c] * q[C_CH + c]); } }
    out[(size_t)m * ldo + c] = p[C_CB + c] * acc;
}

__global__ void cmp_gather_k(const float* proj, int col0, const float* pos, float* A) {
    const size_t idx = (size_t)blockIdx.x * blockDim.x + threadIdx.x;
    if (idx >= (size_t)B * NC * NKV * CMPK) return;
    const int kk = (int)(idx % CMPK); const int r = (int)(idx / CMPK);
    const int h = r % NKV, n = (r / NKV) % NC, b = r / (NKV * NC);
    const int l = kk / HD, d = kk % HD;
    A[idx] = proj[(size_t)(b * S + 16 * n + l) * DIN + col0 + h * HD + d] + pos[l * HD + d];
}
__global__ void gelu_k(float* x, size_t n) {
    const size_t i = (size_t)blockIdx.x * blockDim.x + threadIdx.x;
    if (i >= n) return;
    const float v = x[i];
    x[i] = 0.5f * v * (1.0f + tanhf(0.7978845608028654f * (v + 0.044715f * v * v * v)));
}

__device__ __forceinline__ float block_reduce(float v, bool is_max, float* red) {
    const int tid = threadIdx.x;
    v = is_max ? wave_max(v) : wave_sum(v);
    __syncthreads();
    if ((tid & 63) == 0) red[tid >> 6] = v;
    __syncthreads();
    float r = red[0];
    for (int i = 1; i < 4; ++i) r = is_max ? fmaxf(r, red[i]) : r + red[i];
    return r;
}
__device__ void softmax4(float* sc, int ld, int n, float* red) {
    const int tid = threadIdx.x;
    for (int h = 0; h < 4; ++h) {
        float m = -INFINITY;
        for (int i = tid; i < n; i += 256) m = fmaxf(m, sc[h * ld + i]);
        m = block_reduce(m, true, red);
        if (!(m > -INFINITY)) m = 0.f;
        float s = 0.f;
        for (int i = tid; i < n; i += 256) { const float v = sc[h * ld + i]; const float e = (v > -INFINITY) ? expf(v - m) : 0.f; sc[h * ld + i] = e; s += e; }
        s = block_reduce(s, false, red);
        const float inv = 1.0f / fmaxf(s, 1e-30f);
        for (int i = tid; i < n; i += 256) sc[h * ld + i] *= inv;
        __syncthreads();
    }
}
__global__ void __launch_bounds__(256) nsa_k(const float* proj, const float* KC, const float* VC, float* out, int ldo) {
    __shared__ float q[4][64];
    __shared__ float sc[4][1024];
    __shared__ float imp[128];
    __shared__ int sel[16];
    __shared__ int nsel_s;
    __shared__ float red[4];
    __shared__ float oacc[4][64];
    const int tid = threadIdx.x;
    const int g = blockIdx.x % NKV, m = blockIdx.x / NKV, t = m % S, b = m / S;
    const float* prow = proj + (size_t)m * DIN;
    { const int h = tid >> 6, d = tid & 63; q[h][d] = prow[C_Q + (g * GQ + h) * HD + d]; oacc[h][d] = 0.f; }
    if (tid == 0) nsel_s = 0;
    __syncthreads();
    float slope[4];
#pragma unroll
    for (int h = 0; h < 4; ++h) slope[h] = exp2f(-(float)(g * GQ + h + 1));
    float gate[3];
    { const int h = tid >> 6;
#pragma unroll
      for (int br = 0; br < 3; ++br) { const float gv = prow[C_G + (g * GQ + h) * 3 + br]; gate[br] = 1.0f / (1.0f + expf(-gv)); } }
    for (int i = tid; i < 4 * 512; i += 256) {
        const int h = i >> 9, n = i & 511; float s = -INFINITY;
        if (n < NC && 16 * n + 31 <= t) {
            const float* kr = KC + ((size_t)(b * NC + n) * NKV + g) * HD; float a = 0.f;
            for (int d = 0; d < 64; ++d) a += q[h][d] * kr[d];
            s = a * 0.125f - slope[h] * (float)(t - (16 * n + 31));
        }
        sc[h][n] = s;
    }
    __syncthreads();
    softmax4(&sc[0][0], 1024, 512, red);
    { const int h = tid >> 6, d = tid & 63; float a = 0.f;
      for (int n = 0; n < NC; ++n) { if (16 * n + 31 > t) break; a += sc[h][n] * VC[((size_t)(b * NC + n) * NKV + g) * HD + d]; }
      oacc[h][d] += gate[0] * a; }
    if (tid < 128) {
        const int j = tid; float a = 0.f;
        for (int h = 0; h < 4; ++h) {
            for (int n = 4 * j - 1; n <= 4 * j + 3; ++n) {
                if (n < 0 || n >= NC) continue;
                const int lo = max(16 * n, 64 * j), hi = min(16 * n + 32, 64 * j + 64);
                const float ov = (float)max(hi - lo, 0) / 32.0f;
                a += sc[h][n] * ov;
            }
        }
        if (64 * j > t) a = -INFINITY;
        if (j == 0 || j == t / 64) a = INFINITY;
        imp[j] = a;
    }
    __syncthreads();
    if (tid < 128) {
        const int j = tid; const float v = imp[j]; int rank = 0;
        for (int i = 0; i < 128; ++i) { const float u = imp[i]; rank += (u > v || (u == v && i < j)) ? 1 : 0; }
        if (rank < NTOP) sel[rank] = j;
    }
    __syncthreads();
    for (int i = tid; i < 4 * 1024; i += 256) {
        const int h = i >> 10, mm = i & 1023; const int pos = sel[mm >> 6] * 64 + (mm & 63); float s = -INFINITY;
        if (pos <= t) {
            const float* kr = proj + (size_t)(b * S + pos) * DIN + C_KS + g * HD; float a = 0.f;
            for (int d = 0; d < 64; ++d) a += q[h][d] * kr[d];
            s = a * 0.125f - slope[h] * (float)(t - pos);
        }
        sc[h][mm] = s;
    }
    __syncthreads();
    softmax4(&sc[0][0], 1024, 1024, red);
    { const int h = tid >> 6, d = tid & 63; float a = 0.f;
      for (int mm = 0; mm < 1024; ++mm) { const int pos = sel[mm >> 6] * 64 + (mm & 63); if (pos > t) continue; a += sc[h][mm] * proj[(size_t)(b * S + pos) * DIN + C_VS + g * HD + d]; }
      oacc[h][d] += gate[1] * a; }
    __syncthreads();
    for (int i = tid; i < 4 * 512; i += 256) {
        const int h = i >> 9, mm = i & 511; const int pos = t - 511 + mm; float s = -INFINITY;
        if (pos >= 0) {
            const float* kr = proj + (size_t)(b * S + pos) * DIN + C_KW + g * HD; float a = 0.f;
            for (int d = 0; d < 64; ++d) a += q[h][d] * kr[d];
            s = a * 0.125f - slope[h] * (float)(t - pos);
        }
        sc[h][mm] = s;
    }
    __syncthreads();
    softmax4(&sc[0][0], 1024, 512, red);
    { const int h = tid >> 6, d = tid & 63; float a = 0.f;
      for (int mm = 0; mm < 512; ++mm) { const int pos = t - 511 + mm; if (pos < 0) continue; a += sc[h][mm] * proj[(size_t)(b * S + pos) * DIN + C_VW + g * HD + d]; }
      oacc[h][d] += gate[2] * a;
      out[(size_t)m * ldo + (g * GQ + h) * HD + d] = oacc[h][d]; }
}
}

static void naive_forward(void* const* d_in, float* out, unsigned char* ws, hipStream_t st) {
    using namespace nv;
    const float* x = (const float*)d_in[0]; const float* norm1_g = (const float*)d_in[1]; const float* w_in = (const float*)d_in[2];
    const float* conv_w = (const float*)d_in[3]; const float* kpos = (const float*)d_in[4]; const float* kw1 = (const float*)d_in[5];
    const float* kw2 = (const float*)d_in[6]; const float* vpos = (const float*)d_in[7]; const float* vw1 = (const float*)d_in[8];
    const float* vw2 = (const float*)d_in[9]; const float* gn_conv = (const float*)d_in[10]; const float* gn_nsa = (const float*)d_in[11];
    const float* w_out = (const float*)d_in[12]; const float* norm2_g = (const float*)d_in[13]; const float* w_gate = (const float*)d_in[14];
    const float* w_up = (const float*)d_in[15]; const float* w_down = (const float*)d_in[16]; const float* normf_g = (const float*)d_in[17];
    float* PROJ = (float*)ws;
    float* HB = (float*)(ws + (size_t)M * DIN * 4);
    float* XN = out;
    const int R = B * NC * NKV;
    float* ACMP = HB;
    float* HID = ACMP + (size_t)R * CMPK;
    float* KC = HID + (size_t)R * CH;
    float* VC = KC + (size_t)R * HD;
    rmsnorm_k<<<M / 4, 256, 0, st>>>(x, D, norm1_g, XN, D, M, D);
    gemm_f32<0><<<dim3((DIN + 63) / 64, M / 64), 256, 0, st>>>(XN, D, w_in, DIN, PROJ, DIN, nullptr, 0, M, DIN, D);
    float* MIXED = out;
    conv_k<<<(unsigned)(((size_t)M * CC + 255) / 256), 256, 0, st>>>(PROJ, conv_w, MIXED, D);
    rmsnorm_k<<<M / 4, 256, 0, st>>>(MIXED, D, gn_conv, MIXED, D, M, CC);
    for (int kv = 0; kv < 2; ++kv) {
        cmp_gather_k<<<(unsigned)(((size_t)R * CMPK + 255) / 256), 256, 0, st>>>(PROJ, kv ? C_VC : C_KC, kv ? vpos : kpos, ACMP);
        gemm_f32<0><<<dim3(CH / 64, (R + 63) / 64), 256, 0, st>>>(ACMP, CMPK, kv ? vw1 : kw1, CH, HID, CH, nullptr, 0, R, CH, CMPK);
        gelu_k<<<(unsigned)(((size_t)R * CH + 255) / 256), 256, 0, st>>>(HID, (size_t)R * CH);
        gemm_f32<0><<<dim3(1, (R + 63) / 64), 256, 0, st>>>(HID, CH, kv ? vw2 : kw2, HD, kv ? VC : KC, HD, nullptr, 0, R, HD, CH);
    }
    nsa_k<<<M * NKV, 256, 0, st>>>(PROJ, KC, VC, MIXED + CC, D);
    rmsnorm_k<<<M / 4, 256, 0, st>>>(MIXED + CC, D, gn_nsa, MIXED + CC, D, M, NH * HD);
    gemm_f32<1><<<dim3(D / 64, M / 64), 256, 0, st>>>(MIXED, D, w_out, D, HB, D, x, D, M, D, D);
    float* U2 = out;
    rmsnorm_k<<<M / 4, 256, 0, st>>>(HB, D, norm2_g, U2, D, M, D);
    float* ACT = PROJ;
    gemm_f32<0><<<dim3(DFF / 64, M / 64), 256, 0, st>>>(U2, D, w_gate, DFF, ACT, DFF, nullptr, 0, M, DFF, D);
    gemm_f32<2><<<dim3(DFF / 64, M / 64), 256, 0, st>>>(U2, D, w_up, DFF, ACT, DFF, nullptr, 0, M, DFF, D);
    gemm_f32<1><<<dim3(D / 64, M / 64), 256, 0, st>>>(ACT, DFF, w_down, D, HB, D, HB, D, M, D, DFF);
    rmsnorm_k<<<M / 4, 256, 0, st>>>(HB, D, normf_g, out, D, M, D);
}

extern "C" void kernel_launch(void* const* d_in, const int* in_sizes, int n_in, void* d_out, int out_size, void* d_ws, size_t ws_size, hipStream_t stream) {
    if (n_in != 18 || out_size != nv::M * nv::D || ws_size < (size_t)nv::M * (nv::DIN + nv::D) * 4) { fprintf(stderr, "kernel_launch: unexpected shapes n_in %d out %d ws %zu\n", n_in, out_size, ws_size); return; }
    naive_forward(d_in, (float*)d_out, (unsigned char*)d_ws, stream);
}
```

```cpp
#include <hip/hip_runtime.h>
#include <cstdio>
#include <cstdint>
#include <cmath>
#define MK_SLOW_NSA 0
#define MK_SLOW_CMP 0
#define MK_FUSED 1
namespace pg8 {
#define PG8_LAS __attribute__((address_space(3)))
typedef unsigned short bf16_t;
typedef short bf16x8 __attribute__((ext_vector_type(8)));
typedef float f32x4 __attribute__((ext_vector_type(4)));
typedef unsigned u32x4 __attribute__((ext_vector_type(4)));
constexpr int BM = 256, BK = 64, HALF = 128, HTB = HALF * BK * 2  , STAGE_BYTES = 8 * HTB, NXCD = 8, WGM = 8;

__host__ __device__ __forceinline__ int lds_byte(int r, int c) { const int st = (r >> 4) * 2 + (c >> 5), rr = r & 15, cc = c & 31, ob = rr * 64 + cc * 2; return st * 1024 + (ob ^ (((ob >> 9) & 1) << 5)); }
__host__ __device__ __forceinline__ void stage_rc(int b, int& R, int& C) { const int st = b / 1024, sb = b % 1024, swz = sb ^ (((sb >> 9) & 1) << 5); R = (st >> 1) * 16 + swz / 64; C = (st & 1) * 32 + (swz % 64) / 2; }
__host__ __device__ __forceinline__ int perm32(int rho) { const int n = rho >> 4, i = rho & 15; return 8 * (i >> 2) + 4 * n + (i & 3); }

struct Unit { int pm, pn; };
struct Gemm { const bf16_t* A; const bf16_t* Bt; int M, N, K; };

struct StaticOrder {
    int nM, nN, nwg, G, c;
    __host__ __device__ void init(int M, int N, int G_, int c_) { nM = M / BM; nN = N / BM; nwg = nM * nN; G = G_; c = c_; }
    __host__ __device__ bool next(int i, Unit& u) const {
        const long L = (long)i * G + c; if (L >= nwg) return false;
        int wgid = (int)L; { const int q = nwg / NXCD, r = nwg % NXCD, xcd = wgid % NXCD, off = wgid / NXCD; wgid = (xcd < r ? xcd * (q + 1) : r * (q + 1) + (xcd - r) * q) + off; }
        const int nig = WGM * nN, gid = wgid / nig, fm = gid * WGM, gsz = (nM - fm) < WGM ? (nM - fm) : WGM;
        u.pm = fm + ((wgid % nig) % gsz); u.pn = (wgid % nig) / gsz; return true;
    }
    __device__ __forceinline__ void a_ready(const Unit&) const {}
    __device__ __forceinline__ void done(const Unit&) const {}
};

__device__ __forceinline__ unsigned cvt_pk_bf16(float lo, float hi) { unsigned r; asm volatile("v_cvt_pk_bf16_f32 %0, %1, %2" : "=v"(r) : "v"(lo), "v"(hi)); return r; }
typedef float f32x2 __attribute__((ext_vector_type(2)));
__device__ __forceinline__ f32x2 gelu_pk(f32x2 v) {
    const f32x2 av = __builtin_elementwise_abs(v), d = av * 0.2316418882f + 1.0f;
    f32x2 t; t.x = __builtin_amdgcn_rcpf(d.x); t.y = __builtin_amdgcn_rcpf(d.y);
    f32x2 q = t * 0.5307027145f + (-0.7265760135f); q = q * t + 0.7107068705f; q = q * t + (-0.142248368f); q = q * t + 0.127414796f; q = q * t;
    const f32x2 s = (v * v) * (-0.72134752044f);
    f32x2 e; e.x = __builtin_amdgcn_exp2f(s.x); e.y = __builtin_amdgcn_exp2f(s.y);
    const f32x2 m = v * (q * e), r = v - m;
    f32x2 o; o.x = v.x < 0.f ? m.x : r.x; o.y = v.y < 0.f ? m.y : r.y; return o;
}

template <int ACT  > struct EpiBf16 {
    static constexpr bool PERM = true, AFTER_DRAIN = false; static_assert(ACT == 0 || ACT == 1, "EpiBf16: ACT is 0 (none) or 1 (gelu_pk)");
    bf16_t* O; int ldc; const float* bias; int split_cols; size_t split_stride; float scale0;
    __device__ __forceinline__ void operator()(const f32x4 (&acc)[2][2][4][2], const Unit& u, int wr, int wc, int fr, int fq) const {
        const int row0 = u.pm * BM + wr * 64 + fr; int colt = u.pn * BM; bf16_t* base = O;
        float sc = 1.f; if (split_cols) { const int t = colt / split_cols; base += (size_t)t * split_stride; colt -= t * split_cols; if (t == 0) sc = scale0; }
        const int col0 = colt + wc * 32 + 8 * fq, bcol0 = u.pn * BM + wc * 32 + 8 * fq;
        f32x4 bv[2][2];
#pragma unroll
        for (int bj = 0; bj < 2; ++bj)
#pragma unroll
            for (int n = 0; n < 2; ++n) bv[bj][n] = bias ? *(const f32x4*)(bias + bcol0 + bj * HALF + 4 * n) : (f32x4){0.f, 0.f, 0.f, 0.f};
#pragma unroll
        for (int ai = 0; ai < 2; ++ai)
#pragma unroll
            for (int m = 0; m < 4; ++m) { bf16_t* rowp = base + (size_t)(row0 + ai * HALF + m * 16) * ldc + col0;
#pragma unroll
                for (int bj = 0; bj < 2; ++bj) { f32x4 v0 = acc[ai][bj][m][0] + bv[bj][0], v1 = acc[ai][bj][m][1] + bv[bj][1];
                    if (ACT == 1) { f32x2 a = gelu_pk((f32x2){v0[0], v0[1]}), b = gelu_pk((f32x2){v0[2], v0[3]}), c = gelu_pk((f32x2){v1[0], v1[1]}), d = gelu_pk((f32x2){v1[2], v1[3]});
                        v0 = (f32x4){a.x, a.y, b.x, b.y}; v1 = (f32x4){c.x, c.y, d.x, d.y}; }
                    v0 = v0 * sc; v1 = v1 * sc; u32x4 w; w.x = cvt_pk_bf16(v0[0], v0[1]); w.y = cvt_pk_bf16(v0[2], v0[3]); w.z = cvt_pk_bf16(v1[0], v1[1]); w.w = cvt_pk_bf16(v1[2], v1[3]);
                    *(u32x4*)(rowp + bj * HALF) = w; } }
    }
};

template <class Epi, class Sched, bool ALIGN_EPI = false, bool SP2 = false, bool SWAP = false>
__device__ __forceinline__ void gemm_phase(PG8_LAS unsigned char* lds, const Gemm g, const Sched& S, const Epi& E) {
    const int tid = threadIdx.x, wid = __builtin_amdgcn_readfirstlane(tid >> 6), lane = tid & 63, wr = wid >> 2, wc = wid & 3, fr = lane & 15, fq = lane >> 4;
    const int K = g.K, nt = K / BK;
    unsigned voffA[2], voffB[2];
#pragma unroll
    for (int i = 0; i < 2; ++i) { int R, C; stage_rc(tid * 16 + i * 8192, R, C); const int Rb = Epi::PERM ? ((R & ~31) + perm32(R & 31)) : R;
        voffA[i] = (unsigned)(R * K + C) * 2u; voffB[i] = (unsigned)(Rb * K + C) * 2u; }
    const size_t kstep = (size_t)(BK * 2);
    const size_t hstep = (size_t)HALF * K * 2;
    const size_t tstep = 2 * hstep;
    const unsigned ldsw = (unsigned)wid * 1024u;
    const int aoff = lds_byte(wr * 64 + fr, fq * 8), boff = lds_byte(wc * 32 + fr, fq * 8);
#define PG8_SA(b, h) (((b) * 2 + (h)) * HTB)
#define PG8_SB(b, h) ((4 + (b) * 2 + (h)) * HTB)
#define PG8_STAGE(bufoff, gbase, voff) do { _Pragma("unroll") for (int _i = 0; _i < 2; ++_i) \
        __builtin_amdgcn_global_load_lds((const unsigned*)((const char*)(gbase) + (voff)[_i]), (PG8_LAS unsigned*)(lds + (bufoff) + ldsw + _i * 8192), 16, 0, 0); } while (0)
#define PG8_LDA(dst, b, h) do { _Pragma("unroll") for (int m = 0; m < 4; ++m) _Pragma("unroll") for (int k = 0; k < 2; ++k) dst[m][k] = *(const PG8_LAS bf16x8*)(lds + PG8_SA(b, h) + aoff + m * 2048 + k * 1024); } while (0)
#define PG8_LDB(dst, b, h) do { _Pragma("unroll") for (int n = 0; n < 2; ++n) _Pragma("unroll") for (int k = 0; k < 2; ++k) dst[n][k] = *(const PG8_LAS bf16x8*)(lds + PG8_SB(b, h) + boff + n * 2048 + k * 1024); } while (0)
#define PG8_MMA(ai, bj, At, Bt) do { __builtin_amdgcn_s_setprio(1); _Pragma("unroll") for (int m = 0; m < 4; ++m) _Pragma("unroll") for (int n = 0; n < 2; ++n) _Pragma("unroll") for (int k = 0; k < 2; ++k) \
        acc[ai][bj][m][n] = SWAP ? __builtin_amdgcn_mfma_f32_16x16x32_bf16(At[m][k], Bt[n][k], acc[ai][bj][m][n], 0, 0, 0) : __builtin_amdgcn_mfma_f32_16x16x32_bf16(Bt[n][k], At[m][k], acc[ai][bj][m][n], 0, 0, 0); __builtin_amdgcn_s_setprio(0); } while (0)
#define PG8_WAIT_V(n) asm volatile("s_waitcnt vmcnt(" #n ")" ::: "memory")
#define PG8_WAIT_L(n) asm volatile("s_waitcnt lgkmcnt(" #n ")" ::: "memory")
#define PG8_BAR __builtin_amdgcn_s_barrier()
#define PG8_SCHED __builtin_amdgcn_sched_barrier(0)
    Unit cur, nxt; int ui = 0;
    if (!S.next(0, cur)) return;
    f32x4 acc[2][2][4][2];
#pragma unroll
    for (int a = 0; a < 2; ++a)
#pragma unroll
        for (int b = 0; b < 2; ++b)
#pragma unroll
            for (int m = 0; m < 4; ++m)
#pragma unroll
                for (int n = 0; n < 2; ++n) acc[a][b][m][n] = (f32x4){0.f, 0.f, 0.f, 0.f};
    bf16x8 At[4][2], B0[2][2], B1[2][2];
    const char* cA = (const char*)g.A + (size_t)cur.pm * tstep; const char* cB = (const char*)g.Bt + (size_t)cur.pn * tstep;
    S.a_ready(cur);
    if constexpr (SP2) {
        PG8_STAGE(PG8_SB(0, 0), cB, voffB); PG8_STAGE(PG8_SB(0, 1), cB + hstep, voffB); PG8_STAGE(PG8_SA(0, 0), cA, voffA); PG8_STAGE(PG8_SA(0, 1), cA + hstep, voffA);
        if (wr == 1) PG8_BAR;
        PG8_WAIT_V(2); PG8_BAR;
        PG8_STAGE(PG8_SB(1, 0), cB + kstep, voffB); PG8_STAGE(PG8_SA(1, 0), cA + kstep, voffA); PG8_STAGE(PG8_SB(1, 1), cB + hstep + kstep, voffB);
        PG8_WAIT_V(6); PG8_BAR;
    } else {
        PG8_STAGE(PG8_SB(0, 0), cB, voffB); PG8_STAGE(PG8_SA(0, 0), cA, voffA); PG8_STAGE(PG8_SB(0, 1), cB + hstep, voffB); PG8_STAGE(PG8_SA(0, 1), cA + hstep, voffA);
        if (wr == 1) PG8_BAR;
        PG8_WAIT_V(4); PG8_BAR;
        PG8_STAGE(PG8_SB(1, 0), cB + kstep, voffB); PG8_STAGE(PG8_SA(1, 0), cA + kstep, voffA); PG8_STAGE(PG8_SB(1, 1), cB + hstep + kstep, voffB);
        PG8_WAIT_V(6); PG8_BAR;
    }
    for (;;) {
        const bool has_next = S.next(ui + 1, nxt);
        const char* nA = has_next ? (const char*)g.A + (size_t)nxt.pm * tstep : cA; const char* nB = has_next ? (const char*)g.Bt + (size_t)nxt.pn * tstep : cB;
        for (int t = 0; t < nt; t += 2) {
            const bool last = (t == nt - 2);
            const char* a1 = cA + (size_t)(t + 1) * kstep;
            const char* a2 = last ? nA : cA + (size_t)(t + 2) * kstep; const char* b2 = last ? nB : cB + (size_t)(t + 2) * kstep;
            const char* a3 = a2 + kstep; const char* b3 = b2 + kstep;
            if (last && has_next) S.a_ready(nxt);
            if constexpr (SP2) {
            PG8_LDB(B0, 0, 0); PG8_LDB(B1, 0, 1); PG8_SCHED; PG8_LDA(At, 0, 0); PG8_STAGE(PG8_SA(1, 1), a1 + hstep, voffA);
            PG8_WAIT_V(8); PG8_WAIT_L(0); PG8_BAR; PG8_MMA(0, 0, At, B0); PG8_MMA(0, 1, At, B1); PG8_BAR; PG8_SCHED;
            PG8_LDA(At, 0, 1); PG8_STAGE(PG8_SB(0, 0), b2, voffB); PG8_STAGE(PG8_SB(0, 1), b2 + hstep, voffB); PG8_STAGE(PG8_SA(0, 0), a2, voffA);
            PG8_WAIT_V(8); PG8_WAIT_L(0); PG8_BAR; PG8_MMA(1, 0, At, B0); PG8_MMA(1, 1, At, B1); PG8_BAR; PG8_SCHED;
            PG8_LDB(B0, 1, 0); PG8_LDB(B1, 1, 1); PG8_SCHED; PG8_LDA(At, 1, 0); PG8_STAGE(PG8_SA(0, 1), a2 + hstep, voffA);
            PG8_WAIT_V(8); PG8_WAIT_L(0); PG8_BAR; PG8_MMA(0, 0, At, B0); PG8_MMA(0, 1, At, B1); PG8_BAR; PG8_SCHED;
            PG8_LDA(At, 1, 1); PG8_STAGE(PG8_SB(1, 0), b3, voffB); PG8_STAGE(PG8_SB(1, 1), b3 + hstep, voffB); PG8_STAGE(PG8_SA(1, 0), a3, voffA);
            PG8_WAIT_V(8); PG8_WAIT_L(0); PG8_BAR; PG8_MMA(1, 0, At, B0); PG8_MMA(1, 1, At, B1); PG8_BAR; PG8_SCHED;
            } else {
            PG8_LDB(B0, 0, 0); PG8_SCHED; PG8_LDA(At, 0, 0); PG8_STAGE(PG8_SA(1, 1), a1 + hstep, voffA);
            PG8_WAIT_L(8); PG8_BAR; PG8_WAIT_L(0); PG8_MMA(0, 0, At, B0); PG8_BAR; PG8_SCHED;
            PG8_LDB(B1, 0, 1); PG8_STAGE(PG8_SB(0, 0), b2, voffB);
            PG8_BAR; PG8_WAIT_L(0); PG8_MMA(0, 1, At, B1); PG8_BAR;
            PG8_LDA(At, 0, 1); PG8_STAGE(PG8_SA(0, 0), a2, voffA);
            PG8_BAR; PG8_WAIT_L(0); PG8_MMA(1, 0, At, B0); PG8_BAR; PG8_SCHED;
            PG8_STAGE(PG8_SB(0, 1), b2 + hstep, voffB);
            PG8_WAIT_V(6); PG8_BAR; PG8_MMA(1, 1, At, B1); PG8_BAR;
            PG8_LDB(B0, 1, 0); PG8_SCHED; PG8_LDA(At, 1, 0); PG8_STAGE(PG8_SA(0, 1), a2 + hstep, voffA);
            PG8_WAIT_L(8); PG8_BAR; PG8_WAIT_L(0); PG8_MMA(0, 0, At, B0); PG8_BAR; PG8_SCHED;
            PG8_LDB(B1, 1, 1); PG8_STAGE(PG8_SB(1, 0), b3, voffB);
            PG8_BAR; PG8_WAIT_L(0); PG8_MMA(0, 1, At, B1); PG8_BAR;
            PG8_LDA(At, 1, 1); PG8_STAGE(PG8_SA(1, 0), a3, voffA);
            PG8_BAR; PG8_WAIT_L(0); PG8_MMA(1, 0, At, B0); PG8_BAR; PG8_SCHED;
            PG8_STAGE(PG8_SB(1, 1), b3 + hstep, voffB);
            PG8_WAIT_V(6); PG8_BAR; PG8_MMA(1, 1, At, B1); PG8_BAR;
            }
        }
        if constexpr (ALIGN_EPI) { if (wr == 0) PG8_BAR; }
        if constexpr (!Epi::AFTER_DRAIN) { E(acc, cur, wr, wc, fr, fq); S.done(cur); }
        if (!has_next) break;
#pragma unroll
        for (int a = 0; a < 2; ++a)
#pragma unroll
            for (int b = 0; b < 2; ++b)
#pragma unroll
                for (int m = 0; m < 4; ++m)
#pragma unroll
                    for (int n = 0; n < 2; ++n) acc[a][b][m][n] = (f32x4){0.f, 0.f, 0.f, 0.f};
        cur = nxt; cA = nA; cB = nB; ++ui;
        if constexpr (ALIGN_EPI) { if (wr == 1) PG8_BAR; }
    }
    PG8_WAIT_V(0);
    if constexpr (!ALIGN_EPI) { if (wr == 0) PG8_BAR; }
    PG8_BAR;
    if constexpr (Epi::AFTER_DRAIN) { E.fused(acc, cur, wr, wc, fr, fq, lds, wid, lane); S.done(cur); }
#undef PG8_SA
#undef PG8_SB
#undef PG8_STAGE
#undef PG8_LDA
#undef PG8_LDB
#undef PG8_MMA
#undef PG8_WAIT_V
#undef PG8_WAIT_L
#undef PG8_BAR
#undef PG8_SCHED
}
}
#ifndef PG8_SP2
#define PG8_SP2 true
#endif

constexpr int NWAVES = 8;
constexpr int BATCH = 2, SEQ = 8192, M = BATCH * SEQ, DM = 1024, DIN = 2840, NPROJ = 3072, CC = 512, NH = 8, HD = 64, NKV = 2, GQ = 4;
constexpr int NCMP = 511, NCP = 512, NSEL = 128, NTOP = 16, WIN = 512, DFF = 2816, CMPH = 256, CMPK = 2048;
constexpr int SC_CB = 0, SC_CC = 512, SC_CH = 1024, SC_Q = 1536, SC_KC = 2048, SC_VC = 2176, SC_KS = 2304, SC_VS = 2432, SC_KW = 2560, SC_VW = 2688, SC_G = 2816;
constexpr float EPS = 1e-6f;
constexpr float LOG2E = 1.4426950408889634f;
constexpr float C2 = 0.125f * LOG2E;

constexpr size_t MiB = 1u << 20;
constexpr size_t WS_CTL = 0, CTL_ZERO_BYTES = 1 * MiB;
constexpr size_t WS_SSQ1 = 1 * MiB, WS_SSQ2 = 2 * MiB;
constexpr size_t WS_GATE = 3 * MiB;
constexpr size_t WS_KCMP = 5 * MiB, WS_VCMPT = 5 * MiB + 512 * 1024;
constexpr size_t WS_WIN = 6 * MiB, WS_WOUT = 12 * MiB, WS_WGU = 14 * MiB, WS_WDN = 25 * MiB;
constexpr size_t WS_CW1K = 30 * MiB + 512 * 1024, WS_CW1V = 31 * MiB + 512 * 1024, WS_CW2K = 32 * MiB + 512 * 1024, WS_CW2V = WS_CW2K + 32 * 1024;
constexpr size_t WS_C1P = WS_CW2K + 64 * 1024;
constexpr size_t WS_XN = 34 * MiB;
constexpr size_t WS_CB = 66 * MiB, WS_U = 82 * MiB, WS_Q = 98 * MiB, WS_KCVC = 114 * MiB, WS_KSKW = 122 * MiB, WS_VST = 130 * MiB, WS_VWT = 134 * MiB;
constexpr size_t WS_MIXED = 138 * MiB;
constexpr size_t WS_ACT = 66 * MiB;
constexpr size_t WS_NSAOUT = 170 * MiB, WS_ACMP = 202 * MiB, WS_HID = 220 * MiB, WS_COUT = 223 * MiB;
constexpr size_t WS_END = 256 * MiB;
constexpr int CW_TMO = 0, CW_CODE = 1, CW_BAR = 4096;

constexpr int RING_OFF = 0, RING_BYTES = 131072;
constexpr int LDSCTL_OFF = RING_BYTES, MISC_OFF = LDSCTL_OFF + 320;
constexpr int LDS_BYTES = 147456;

#define GAS __attribute__((address_space(1)))
#define LAS __attribute__((address_space(3)))
typedef unsigned short bf16;
typedef unsigned v4u __attribute__((ext_vector_type(4)));
typedef unsigned v2u __attribute__((ext_vector_type(2)));
typedef float f32x4 __attribute__((ext_vector_type(4)));
typedef short bf16x8 __attribute__((ext_vector_type(8)));
typedef GAS unsigned gu32;
#define RLX_AGENT __ATOMIC_RELAXED, __HIP_MEMORY_SCOPE_AGENT
#define LDS_WAIT() asm volatile("s_waitcnt lgkmcnt(0)" ::: "memory")
#define VM_WAIT() asm volatile("s_waitcnt vmcnt(0)" ::: "memory")
__device__ __forceinline__ unsigned f2bf(float f) { unsigned u = __builtin_bit_cast(unsigned, f); return (u + 0x7fffu + ((u >> 16) & 1u)) >> 16; }
__device__ __forceinline__ unsigned pk2(float lo, float hi) { return f2bf(lo) | (f2bf(hi) << 16); }
__device__ __forceinline__ float bf2f(unsigned b) { return __uint_as_float(b << 16); }
__device__ __forceinline__ float bflo(unsigned w) { return __uint_as_float(w << 16); }
__device__ __forceinline__ float bfhi(unsigned w) { return __uint_as_float(w & 0xffff0000u); }

#define XB_TMO      128
#define XB_XCNT(j)  (256  + 64 * (j))
#define XB_XSUB(j)  (1280 + 64 * (j))
#define XB_XGEN(j)  (2304 + 64 * (j))
#define XB_TOP      3328
#define XB_TOPGEN   3392
#define XCD_BAR_WORDS 3456
#define XB_SPIN_CAP (1u << 18)
__device__ __forceinline__ unsigned xb_ld(unsigned* p)              { return __hip_atomic_load(p, __ATOMIC_RELAXED, __HIP_MEMORY_SCOPE_AGENT); }
__device__ __forceinline__ unsigned xb_add(unsigned* p, unsigned v) { return __hip_atomic_fetch_add(p, v, __ATOMIC_RELAXED, __HIP_MEMORY_SCOPE_AGENT); }
__device__ __forceinline__ unsigned xb_xcc_id() { return (unsigned)__builtin_amdgcn_s_getreg((3 << 11) | 20) & 0xFu; }
#define XB_SPIN(cond, bar) do { unsigned _sp = 0; while (cond) { __builtin_amdgcn_s_sleep(1); \
    if ((++_sp & 255u) == 0u) { if (xb_ld(&(bar)[XB_TMO])) break; if (_sp > XB_SPIN_CAP) { atomicAdd(&(bar)[XB_TMO], 1u); break; } } } } while (0)
struct XcdBarrier { unsigned* bar; unsigned x; volatile LAS unsigned* st; };
__device__ __forceinline__ XcdBarrier xcd_barrier_post(unsigned* bar, volatile LAS unsigned* st) {
    XcdBarrier b; b.bar = bar; b.x = xb_xcc_id(); b.st = st;
    if (threadIdx.x == 0) (void)xb_add(&bar[XB_XCNT(b.x)], 1u);
    return b;
}
__device__ __forceinline__ void xcd_barrier_complete(unsigned* bar, unsigned x, unsigned& nloc, unsigned& nx) {
    const unsigned G = gridDim.x * gridDim.y * gridDim.z;
    unsigned sum, cnt, mine, sp = 0u;
    for (;;) {
        sum = 0u; cnt = 0u; mine = 0u;
#pragma unroll
        for (unsigned j = 0; j < 16; ++j) { const unsigned c = xb_ld(&bar[XB_XCNT(j)]); sum += c; cnt += (c > 0u) ? 1u : 0u; mine = (j == x) ? c : mine; }
        if (sum == G) break;
        __builtin_amdgcn_s_sleep(1);
        if ((++sp & 255u) == 0u) { if (xb_ld(&bar[XB_TMO])) break; if (sp > XB_SPIN_CAP) { atomicAdd(&bar[XB_TMO], 1u); break; } }
    }
    nloc = mine > 0u ? mine : 1u; nx = cnt > 0u ? cnt : 1u;
}
__device__ __forceinline__ void xcd_barrier(const XcdBarrier& b) {
    asm volatile("s_waitcnt vmcnt(0)" ::: "memory");
    __syncthreads();
    if (threadIdx.x == 0) {
        unsigned* bar = b.bar;
        __builtin_amdgcn_s_waitcnt(0);
        unsigned nloc = b.st[0], nx = b.st[1];
        if (nloc == 0u) { xcd_barrier_complete(bar, b.x, nloc, nx); b.st[0] = nloc; b.st[1] = nx; }
        const unsigned old = xb_add(&bar[XB_XSUB(b.x)], 1u);
        const unsigned gen = old / nloc;
        if (old + 1u == (gen + 1u) * nloc) {
            __builtin_amdgcn_fence(__ATOMIC_RELEASE, "agent");
            asm volatile("s_waitcnt vmcnt(0)" ::: "memory");
            const unsigned og = xb_add(&bar[XB_TOP], 1u);
            const unsigned tg = og / nx;
            if (og + 1u == (tg + 1u) * nx) xb_add(&bar[XB_TOPGEN], 1u);
            else XB_SPIN(xb_ld(&bar[XB_TOPGEN]) == tg, bar);
            __builtin_amdgcn_fence(__ATOMIC_ACQUIRE, "agent");
            xb_add(&bar[XB_XGEN(b.x)], 1u);
            asm volatile("s_waitcnt vmcnt(0)" ::: "memory");
        } else {
            XB_SPIN(xb_ld(&bar[XB_XGEN(b.x)]) == gen, bar);
            __builtin_amdgcn_fence(__ATOMIC_ACQUIRE, "agent");
            asm volatile("s_waitcnt vmcnt(0)" ::: "memory");
        }
    }
    __syncthreads();
}

struct Frame {
    LAS unsigned char* lds;
    volatile LAS unsigned* MISC;
    gu32* ctl;
    int tid, lane, wave;
    int vcu, G;
    const float* in[18];
    float* out; unsigned char* ws;
};
__device__ __forceinline__ float wave_sum(float v) {
#pragma unroll
    for (int o = 1; o < 64; o <<= 1) v += __shfl_xor(v, o);
    return v;
}

namespace pg8 {
struct EpiInProj {
    static constexpr bool PERM = true, AFTER_DRAIN = false;
    bf16_t *CB, *U, *Q, *KCVC, *KSKW; float* GATE;
    __device__ __forceinline__ void operator()(const f32x4 (&acc)[2][2][4][2], const Unit& u, int wr, int wc, int fr, int fq) const {
        const int row0 = u.pm * BM + wr * 64 + fr; const int pn = u.pn;
        if (pn >= 2 && pn <= 5) {
#pragma unroll
            for (int ai = 0; ai < 2; ++ai)
#pragma unroll
                for (int m = 0; m < 4; ++m) { bf16_t* rowp = U + (size_t)(row0 + ai * HALF + m * 16) * 512 + (pn - 2) * 128 + wc * 32 + 8 * fq;
                    const f32x4 v0 = acc[ai][0][m][0] * acc[ai][1][m][0], v1 = acc[ai][0][m][1] * acc[ai][1][m][1];
                    u32x4 w; w.x = cvt_pk_bf16(v0[0], v0[1]); w.y = cvt_pk_bf16(v0[2], v0[3]); w.z = cvt_pk_bf16(v1[0], v1[1]); w.w = cvt_pk_bf16(v1[2], v1[3]);
                    *(u32x4*)rowp = w; }
        } else if (pn == 11) {
            if (wc == 0 && fq < 3) {
#pragma unroll
                for (int ai = 0; ai < 2; ++ai)
#pragma unroll
                    for (int m = 0; m < 4; ++m) { float* gp = GATE + (size_t)(row0 + ai * HALF + m * 16) * 32 + 8 * fq;
#pragma unroll
                        for (int n = 0; n < 2; ++n) { const f32x4 v = acc[ai][0][m][n]; f32x4 o;
#pragma unroll
                            for (int i = 0; i < 4; ++i) o[i] = __builtin_amdgcn_rcpf(1.0f + __builtin_amdgcn_exp2f(-v[i] * 1.4426950408889634f));
                            *(f32x4*)(gp + 4 * n) = o; } }
            }
        } else {
            bf16_t* base; int ld, coff; float sc = 1.f;
            if (pn < 2) { base = CB; ld = 512; coff = pn * 256; }
            else if (pn < 8) { base = Q; ld = 512; coff = (pn - 6) * 256; sc = 0.125f * 1.4426950408889634f; }
            else if (pn == 8) { base = KCVC; ld = 256; coff = 0; }
            else { base = KSKW; ld = 256; coff = 0; }
#pragma unroll
            for (int ai = 0; ai < 2; ++ai)
#pragma unroll
                for (int m = 0; m < 4; ++m) { bf16_t* rowp = base + (size_t)(row0 + ai * HALF + m * 16) * ld + coff + wc * 32 + 8 * fq;
#pragma unroll
                    for (int bj = 0; bj < 2; ++bj) { const f32x4 v0 = acc[ai][bj][m][0] * sc, v1 = acc[ai][bj][m][1] * sc;
                        u32x4 w; w.x = cvt_pk_bf16(v0[0], v0[1]); w.y = cvt_pk_bf16(v0[2], v0[3]); w.z = cvt_pk_bf16(v1[0], v1[1]); w.w = cvt_pk_bf16(v1[2], v1[3]);
                        *(u32x4*)(rowp + bj * HALF) = w; } }
        }
    }
};
struct EpiVT {
    static constexpr bool PERM = false, AFTER_DRAIN = false;
    bf16_t *VST, *VWT;
    __device__ __forceinline__ void operator()(const f32x4 (&acc)[2][2][4][2], const Unit& u, int wr, int wc, int fr, int fq) const {
#pragma unroll
        for (int ai = 0; ai < 2; ++ai) {
            const int tok0 = u.pm * BM + ai * HALF + wr * 64; const int b = tok0 / 8192, blk = (tok0 % 8192) / 64;
#pragma unroll
            for (int bj = 0; bj < 2; ++bj)
#pragma unroll
                for (int n = 0; n < 2; ++n) { const int col = wc * 32 + n * 16 + fr, g = col >> 6, d = col & 63;
                    bf16_t* dp = (bj ? VWT : VST) + ((size_t)(((b * 2 + g) * 128 + blk) * 64 + d)) * 64 + 8 * (fq & 1) + 4 * (fq >> 1);
#pragma unroll
                    for (int m = 0; m < 4; ++m) { const f32x4 v = acc[ai][bj][m][n]; typedef unsigned u32x2 __attribute__((ext_vector_type(2)));
                        u32x2 w; w.x = cvt_pk_bf16(v[0], v[1]); w.y = cvt_pk_bf16(v[2], v[3]); *(u32x2*)(dp + 16 * m) = w; } }
        }
    }
};
struct EpiOutProj {
    static constexpr bool PERM = false, AFTER_DRAIN = false;
    const float* X; float* H; bf16_t* HBF; float* SSQ;
    __device__ __forceinline__ void operator()(const f32x4 (&acc)[2][2][4][2], const Unit& u, int wr, int wc, int fr, int fq) const {
        const int col0 = u.pn * BM + wc * 32 + 4 * fq;
#pragma unroll
        for (int ai = 0; ai < 2; ++ai)
#pragma unroll
            for (int m = 0; m < 4; ++m) { const int row = u.pm * BM + ai * HALF + wr * 64 + m * 16 + fr; const size_t off = (size_t)row * 1024 + col0; float s = 0.f;
#pragma unroll
                for (int bj = 0; bj < 2; ++bj)
#pragma unroll
                    for (int n = 0; n < 2; ++n) { const f32x4 h = *(const f32x4*)(X + off + bj * HALF + n * 16) + acc[ai][bj][m][n];
                        *(f32x4*)(H + off + bj * HALF + n * 16) = h; typedef unsigned u32x2 __attribute__((ext_vector_type(2)));
                        u32x2 w; w.x = cvt_pk_bf16(h[0], h[1]); w.y = cvt_pk_bf16(h[2], h[3]); *(u32x2*)(HBF + off + bj * HALF + n * 16) = w;
                        s += (h[0] * h[0] + h[1] * h[1]) + (h[2] * h[2] + h[3] * h[3]); }
                s += __shfl_xor(s, 16); s += __shfl_xor(s, 32);
                if (fq == 0) SSQ[(size_t)row * 16 + u.pn * 4 + wc] = s;
                asm volatile("" ::: "memory"); }
    }
};
struct EpiDown {
    static constexpr bool PERM = false, AFTER_DRAIN = false;
    float* H; float* SSQ;
    __device__ __forceinline__ void operator()(const f32x4 (&acc)[2][2][4][2], const Unit& u, int wr, int wc, int fr, int fq) const {
        const int col0 = u.pn * BM + wc * 32 + 4 * fq;
#pragma unroll
        for (int ai = 0; ai < 2; ++ai)
#pragma unroll
            for (int m = 0; m < 4; ++m) { const int row = u.pm * BM + ai * HALF + wr * 64 + m * 16 + fr; const size_t off = (size_t)row * 1024 + col0; float s = 0.f;
#pragma unroll
                for (int bj = 0; bj < 2; ++bj)
#pragma unroll
                    for (int n = 0; n < 2; ++n) { const f32x4 h = *(const f32x4*)(H + off + bj * HALF + n * 16) + acc[ai][bj][m][n];
                        *(f32x4*)(H + off + bj * HALF + n * 16) = h;
                        s += (h[0] * h[0] + h[1] * h[1]) + (h[2] * h[2] + h[3] * h[3]); }
                s += __shfl_xor(s, 16); s += __shfl_xor(s, 32);
                if (fq == 0) SSQ[(size_t)row * 16 + u.pn * 4 + wc] = s;
                asm volatile("" ::: "memory"); }
    }
};
struct EpiSwiGLU {
    static constexpr bool PERM = true, AFTER_DRAIN = false;
    const float* SSQ; bf16_t* ACT;
    __device__ __forceinline__ void operator()(const f32x4 (&acc)[2][2][4][2], const Unit& u, int wr, int wc, int fr, int fq) const {
        const int row0 = u.pm * BM + wr * 64 + fr;
#pragma unroll
        for (int ai = 0; ai < 2; ++ai)
#pragma unroll
            for (int m = 0; m < 4; ++m) { const int row = row0 + ai * HALF + m * 16; const f32x4* sp = (const f32x4*)(SSQ + (size_t)row * 16);
                const f32x4 a = sp[0], b = sp[1], c = sp[2], d = sp[3];
                const float ss = ((a[0] + a[1]) + (a[2] + a[3])) + ((b[0] + b[1]) + (b[2] + b[3])) + ((c[0] + c[1]) + (c[2] + c[3])) + ((d[0] + d[1]) + (d[2] + d[3]));
                const float rs = 1.0f / sqrtf(ss * (1.0f / 1024.0f) + 1e-6f);
                float o[8];
#pragma unroll
                for (int n = 0; n < 2; ++n)
#pragma unroll
                    for (int i = 0; i < 4; ++i) { const float g = acc[ai][0][m][n][i] * rs, up = acc[ai][1][m][n][i] * rs;
                        o[4 * n + i] = g * __builtin_amdgcn_rcpf(1.0f + __builtin_amdgcn_exp2f(-g * 1.4426950408889634f)) * up; }
                u32x4 w; w.x = cvt_pk_bf16(o[0], o[1]); w.y = cvt_pk_bf16(o[2], o[3]); w.z = cvt_pk_bf16(o[4], o[5]); w.w = cvt_pk_bf16(o[6], o[7]);
                *(u32x4*)(ACT + (size_t)row * 2816 + u.pn * 128 + wc * 32 + 8 * fq) = w;
                asm volatile("" ::: "memory"); }
    }
};
struct OrderInA { StaticOrder S;
    __device__ bool next(int i, Unit& u) const { const bool ok = S.next(i, u); if (ok && u.pn == 10) u.pn = 11; return ok; }
    __device__ __forceinline__ void a_ready(const Unit&) const {}
    __device__ __forceinline__ void done(const Unit&) const {} };
struct OrderInB { int G, c;
    __device__ bool next(int i, Unit& u) const { const int L = i * G + (c + G - (192 % G)) % G; if (L >= 64) return false; u.pm = L; u.pn = 10; return true; }
    __device__ __forceinline__ void a_ready(const Unit&) const {}
    __device__ __forceinline__ void done(const Unit&) const {} };
}

__device__ __forceinline__ void p0_item(const float* W, int N, int k0, int n0, int nvalid, const float* gk, bf16* WT, int ldw, int drow0, LAS float* scr, int lane) {
#pragma unroll 8
    for (int i = 0; i < 32; ++i) { const int kk = 2 * i + (lane >> 5), n = lane & 31;
        float v = (n < nvalid) ? W[(size_t)(k0 + kk) * N + n0 + n] : 0.f; if (gk) v *= gk[k0 + kk]; scr[kk * 33 + n] = v; }
    LDS_WAIT(); asm volatile("" ::: "memory");
    const int c = lane & 7;
#pragma unroll
    for (int j = 0; j < 4; ++j) { const int n = (lane >> 3) + 8 * j; const LAS float* s = scr + (8 * c) * 33 + n;
        v4u o; o.x = pk2(s[0 * 33], s[1 * 33]); o.y = pk2(s[2 * 33], s[3 * 33]); o.z = pk2(s[4 * 33], s[5 * 33]); o.w = pk2(s[6 * 33], s[7 * 33]);
        *(GAS v4u*)(WT + (size_t)(drow0 + n) * ldw + k0 + 8 * c) = o; }
    LDS_WAIT(); asm volatile("" ::: "memory");
}
__device__ __forceinline__ int win_dst_row(int n0) {
    if (n0 < SC_CC) return n0;
    if (n0 < SC_CH) { const int c = n0 - SC_CC; return 256 * (2 + (c >> 7)) + (c & 127); }
    if (n0 < SC_Q) { const int c = n0 - SC_CH; return 256 * (2 + (c >> 7)) + 128 + (c & 127); }
    if (n0 < SC_VS) return n0;
    if (n0 < SC_KW) return n0 + 128;
    if (n0 < SC_VW) return n0 - 128;
    return n0;
}
__device__ __forceinline__ void rms_row_to_bf16(const float* xrow, const float* g, bf16* orow, int lane) {
    const GAS f32x4* xr = (const GAS f32x4*)xrow + lane; const GAS f32x4* gr = (const GAS f32x4*)g + lane;
    f32x4 v[4]; float s = 0.f;
#pragma unroll
    for (int j = 0; j < 4; ++j) { v[j] = xr[64 * j]; s += (v[j].x * v[j].x + v[j].y * v[j].y) + (v[j].z * v[j].z + v[j].w * v[j].w); }
    const float r = 1.0f / sqrtf(wave_sum(s) * (1.0f / 1024.0f) + EPS);
    GAS unsigned long long* o8 = (GAS unsigned long long*)orow + lane;
#pragma unroll
    for (int j = 0; j < 4; ++j) { const f32x4 gv = gr[64 * j];
        o8[64 * j] = (unsigned long long)pk2(v[j].x * r * gv.x, v[j].y * r * gv.y) | ((unsigned long long)pk2(v[j].z * r * gv.z, v[j].w * r * gv.w) << 32); }
}
__device__ __forceinline__ void p0_prologue(Frame& F) {
    LAS float* scr = (LAS float*)(F.lds + RING_OFF + F.wave * 16384);
    const int gw = F.vcu * NWAVES + F.wave, NGW = F.G * NWAVES;
    bf16* WIN_T = (bf16*)(F.ws + WS_WIN); bf16* WOUT_T = (bf16*)(F.ws + WS_WOUT); bf16* WGU_T = (bf16*)(F.ws + WS_WGU); bf16* WDN_T = (bf16*)(F.ws + WS_WDN);
    constexpr int I_IN = 16 * 89, I_OUT = 16 * 32, I_G = 16 * 88, I_U = 16 * 88, I_DN = 44 * 32, I_C1 = 32 * 8, I_C2 = 4 * 2, I_Z = 448, I_P = 128;
    constexpr int NITEMS = I_IN + I_OUT + I_G + I_U + I_DN + 2 * I_C1 + 2 * I_C2 + I_Z + I_P;
    for (int it = gw; it < NITEMS; it += NGW) {
        int r = it;
        if (r < I_IN) { const int kb = r / 89, nb = r % 89, n0 = 32 * nb; p0_item(F.in[2], DIN, 64 * kb, n0, min(32, DIN - n0), nullptr, WIN_T, 1024, win_dst_row(n0), scr, F.lane); continue; } r -= I_IN;
        if (r < I_OUT) { const int kb = r / 32, nb = r % 32; p0_item(F.in[12], 1024, 64 * kb, 32 * nb, 32, nullptr, WOUT_T, 1024, 32 * nb, scr, F.lane); continue; } r -= I_OUT;
        if (r < I_G) { const int kb = r / 88, nb = r % 88, n0 = 32 * nb; p0_item(F.in[14], DFF, 64 * kb, n0, 32, F.in[13], WGU_T, 1024, 256 * (n0 >> 7) + (n0 & 127), scr, F.lane); continue; } r -= I_G;
        if (r < I_U) { const int kb = r / 88, nb = r % 88, n0 = 32 * nb; p0_item(F.in[15], DFF, 64 * kb, n0, 32, F.in[13], WGU_T, 1024, 256 * (n0 >> 7) + 128 + (n0 & 127), scr, F.lane); continue; } r -= I_U;
        if (r < I_DN) { const int kb = r / 32, nb = r % 32; p0_item(F.in[16], 1024, 64 * kb, 32 * nb, 32, nullptr, WDN_T, DFF, 32 * nb, scr, F.lane); continue; } r -= I_DN;
        if (r < I_C1) { const int kb = r / 8, nb = r % 8; p0_item(F.in[5], CMPH, 64 * kb, 32 * nb, 32, nullptr, (bf16*)(F.ws + WS_CW1K), CMPK, 32 * nb, scr, F.lane); continue; } r -= I_C1;
        if (r < I_C1) { const int kb = r / 8, nb = r % 8; p0_item(F.in[8], CMPH, 64 * kb, 32 * nb, 32, nullptr, (bf16*)(F.ws + WS_CW1V), CMPK, 32 * nb, scr, F.lane); continue; } r -= I_C1;
        if (r < I_C2) { const int kb = r / 2, nb = r % 2; p0_item(F.in[6], HD, 64 * kb, 32 * nb, 32, nullptr, (bf16*)(F.ws + WS_CW2K), CMPH, 32 * nb, scr, F.lane); continue; } r -= I_C2;
        if (r < I_C2) { const int kb = r / 2, nb = r % 2; p0_item(F.in[9], HD, 64 * kb, 32 * nb, 32, nullptr, (bf16*)(F.ws + WS_CW2V), CMPH, 32 * nb, scr, F.lane); continue; } r -= I_C2;
        if (r < I_Z) { GAS v4u* z = (GAS v4u*)(WIN_T + (size_t)2848 * 1024) + (size_t)r * 64 + F.lane; *z = (v4u){0u, 0u, 0u, 0u}; continue; } r -= I_Z;
        { const int kv = r >> 6, ch = (r >> 2) & 15, cg = r & 3, col = 64 * cg + F.lane; const float* pos = F.in[kv ? 7 : 4]; const float* w1 = F.in[kv ? 8 : 5]; float a = 0.f;
#pragma unroll 16
          for (int k = 128 * ch; k < 128 * ch + 128; ++k) a = fmaf(pos[k], w1[(size_t)k * CMPH + col], a);
          ((float*)(F.ws + WS_C1P))[(kv * 16 + ch) * 256 + col] = a; }
    }
    for (int m = gw; m < M; m += NGW) rms_row_to_bf16(F.in[0] + (size_t)m * DM, F.in[1], (bf16*)(F.ws + WS_XN) + (size_t)m * DM, F.lane);
}

__device__ __forceinline__ void conv_token(const bf16* CB, const bf16* U, const float* cw, const float* gn, bf16* MIXED, int m, int lane) {
    const int t = m & (SEQ - 1);
    const v4u cb = *(const GAS v4u*)(CB + (size_t)m * 512 + 8 * lane);
    const v4u u2 = *(const GAS v4u*)(U + (size_t)m * 512 + 8 * lane);
    v4u u1 = (v4u){0u, 0u, 0u, 0u}, u0 = (v4u){0u, 0u, 0u, 0u};
    if (t >= 1) u1 = *(const GAS v4u*)(U + (size_t)(m - 1) * 512 + 8 * lane);
    if (t >= 2) u0 = *(const GAS v4u*)(U + (size_t)(m - 2) * 512 + 8 * lane);
    float y[8]; float s = 0.f;
#pragma unroll
    for (int i = 0; i < 4; ++i) {
        const int c = 8 * lane + 2 * i;
        const float a0 = cw[c] * bflo(u0[i]) + cw[512 + c] * bflo(u1[i]) + cw[1024 + c] * bflo(u2[i]);
        const float a1 = cw[c + 1] * bfhi(u0[i]) + cw[512 + c + 1] * bfhi(u1[i]) + cw[1024 + c + 1] * bfhi(u2[i]);
        y[2 * i] = bflo(cb[i]) * a0; y[2 * i + 1] = bfhi(cb[i]) * a1; s += y[2 * i] * y[2 * i] + y[2 * i + 1] * y[2 * i + 1];
    }
    const float r = 1.0f / sqrtf(wave_sum(s) * (1.0f / 512.0f) + EPS);
    v4u o;
#pragma unroll
    for (int i = 0; i < 4; ++i) { const int c = 8 * lane + 2 * i; o[i] = pk2(y[2 * i] * r * gn[c], y[2 * i + 1] * r * gn[c + 1]); }
    *(GAS v4u*)(MIXED + (size_t)m * 1024 + 8 * lane) = o;
}
__device__ __forceinline__ void final_row(const float* H, const float* SSQ, const float* g, float* out, int m, int lane) {
    const GAS f32x4* sp = (const GAS f32x4*)(SSQ + (size_t)m * 16);
    const f32x4 a = sp[0], b = sp[1], c = sp[2], d = sp[3];
    const float ss = ((a[0] + a[1]) + (a[2] + a[3])) + ((b[0] + b[1]) + (b[2] + b[3])) + ((c[0] + c[1]) + (c[2] + c[3])) + ((d[0] + d[1]) + (d[2] + d[3]));
    const float r = 1.0f / sqrtf(ss * (1.0f / 1024.0f) + EPS);
    const GAS f32x4* hr = (const GAS f32x4*)(H + (size_t)m * DM) + lane; const GAS f32x4* gr = (const GAS f32x4*)g + lane; GAS f32x4* o = (GAS f32x4*)(out + (size_t)m * DM) + lane;
    f32x4 v[4];
#pragma unroll
    for (int j = 0; j < 4; ++j) v[j] = hr[64 * j];
#pragma unroll
    for (int j = 0; j < 4; ++j) o[64 * j] = v[j] * r * gr[64 * j];
}

namespace slow {
__device__ __forceinline__ float wave_max(float v) {
#pragma unroll
    for (int o = 1; o < 64; o <<= 1) v = fmaxf(v, __shfl_xor(v, o));
    return v;
}
__device__ __forceinline__ int kslot(int k) { return 16 * (k >> 4) + 8 * ((k >> 2) & 1) + (k & 3) + 4 * ((k & 15) >> 3); }
template <int EPI>
__global__ void __launch_bounds__(256) gemm_f32(const float* A, int lda, const float* Bm, int ldb, float* C, int ldc, int Mr, int N, int K) {
    __shared__ float As[16][68];
    __shared__ float Bs[16][68];
    const int tid = threadIdx.x, tx = tid & 15, ty = tid >> 4;
    const int m0 = blockIdx.y * 64, n0 = blockIdx.x * 64;
    float acc[4][4];
#pragma unroll
    for (int i = 0; i < 4; ++i)
#pragma unroll
        for (int j = 0; j < 4; ++j) acc[i][j] = 0.f;
    const int ar = tid >> 2, ak = (tid & 3) * 4;
    const int bk = tid >> 4, bc = (tid & 15) * 4;
    for (int k0 = 0; k0 < K; k0 += 16) {
        float4 av = make_float4(0.f, 0.f, 0.f, 0.f), bv = make_float4(0.f, 0.f, 0.f, 0.f);
        if (m0 + ar < Mr) av = *(const float4*)(A + (size_t)(m0 + ar) * lda + k0 + ak);
        if (n0 + bc < N) bv = *(const float4*)(Bm + (size_t)(k0 + bk) * ldb + n0 + bc);
        __syncthreads();
        As[ak + 0][ar] = av.x; As[ak + 1][ar] = av.y; As[ak + 2][ar] = av.z; As[ak + 3][ar] = av.w;
        *(float4*)&Bs[bk][bc] = bv;
        __syncthreads();
#pragma unroll
        for (int k = 0; k < 16; ++k) {
            const float4 a = *(const float4*)&As[k][ty * 4];
            const float4 b = *(const float4*)&Bs[k][tx * 4];
            const float aa[4] = {a.x, a.y, a.z, a.w}, bb[4] = {b.x, b.y, b.z, b.w};
#pragma unroll
            for (int i = 0; i < 4; ++i)
#pragma unroll
                for (int j = 0; j < 4; ++j) acc[i][j] = fmaf(aa[i], bb[j], acc[i][j]);
        }
    }
#pragma unroll
    for (int i = 0; i < 4; ++i) {
        const int r = m0 + ty * 4 + i;
        if (r >= Mr) continue;
#pragma unroll
        for (int j = 0; j < 4; ++j) {
            const int c = n0 + tx * 4 + j;
            if (c >= N) continue;
            float v = acc[i][j];
            if (EPI == 1) v = 0.5f * v * (1.0f + tanhf(0.7978845608028654f * (v + 0.044715f * v * v * v)));
            C[(size_t)r * ldc + c] = v;
        }
    }
}
__global__ void cmp_gather_k(const bf16* KCVC, int coloff, const float* pos, float* A) {
    const size_t idx = (size_t)blockIdx.x * blockDim.x + threadIdx.x;
    if (idx >= (size_t)BATCH * NCMP * NKV * CMPK) return;
    const int kk = (int)(idx % CMPK); const int r = (int)(idx / CMPK);
    const int h = r % NKV, n = (r / NKV) % NCMP, b = r / (NKV * NCMP);
    const int l = kk / HD, d = kk % HD;
    A[idx] = bf2f(KCVC[(size_t)(b * SEQ + 16 * n + l) * 256 + coloff + h * HD + d]) + pos[l * HD + d];
}
__global__ void cmp_pack_k(const float* COUT, int isV, bf16* dst) {
    const int idx = blockIdx.x * blockDim.x + threadIdx.x;
    if (idx >= BATCH * NKV * NCP * HD) return;
    const int d = idx % HD, n = (idx / HD) % NCP, h = (idx / (HD * NCP)) % NKV, b = idx / (HD * NCP * NKV);
    const float v = (n < NCMP) ? COUT[(size_t)((b * NCMP + n) * NKV + h) * HD + d] : 0.f;
    if (!isV) dst[(size_t)((b * NKV + h) * NCP + n) * HD + d] = (bf16)f2bf(v);
    else dst[(size_t)((b * NKV + h) * HD + d) * NCP + (n & ~63) + kslot(n & 63)] = (bf16)f2bf(v);
}
__device__ __forceinline__ float block_reduce(float v, bool is_max, float* red) {
    const int tid = threadIdx.x;
    v = is_max ? wave_max(v) : wave_sum(v);
    __syncthreads();
    if ((tid & 63) == 0) red[tid >> 6] = v;
    __syncthreads();
    float r = red[0];
    for (int i = 1; i < 4; ++i) r = is_max ? fmaxf(r, red[i]) : r + red[i];
    return r;
}
__device__ void softmax4(float* sc, int ld, int n, float* red) {
    const int tid = threadIdx.x;
    for (int h = 0; h < 4; ++h) {
        float m = -INFINITY;
        for (int i = tid; i < n; i += 256) m = fmaxf(m, sc[h * ld + i]);
        m = block_reduce(m, true, red);
        if (!(m > -INFINITY)) m = 0.f;
        float s = 0.f;
        for (int i = tid; i < n; i += 256) { const float v = sc[h * ld + i]; const float e = (v > -INFINITY) ? exp2f(v - m) : 0.f; sc[h * ld + i] = e; s += e; }
        s = block_reduce(s, false, red);
        const float inv = 1.0f / fmaxf(s, 1e-30f);
        for (int i = tid; i < n; i += 256) sc[h * ld + i] *= inv;
        __syncthreads();
    }
}
__global__ void __launch_bounds__(256) nsa_k(const bf16* Q, const bf16* KCMP, const bf16* VCMPT, const bf16* KSKW, const bf16* VST, const bf16* VWT, const float* GATE, float* out) {
    __shared__ float q[4][64];
    __shared__ float sc[4][1024];
    __shared__ float imp[128];
    __shared__ int sel[16];
    __shared__ float red[4];
    __shared__ float oacc[4][64];
    const int tid = threadIdx.x;
    const int g = blockIdx.x % NKV, m = blockIdx.x / NKV, t = m % SEQ, b = m / SEQ;
    { const int h = tid >> 6, d = tid & 63; q[h][d] = bf2f(Q[(size_t)m * 512 + (g * GQ + h) * HD + d]); oacc[h][d] = 0.f; }
    __syncthreads();
    float slope[4];
#pragma unroll
    for (int h = 0; h < 4; ++h) slope[h] = exp2f(-(float)(g * GQ + h + 1)) * LOG2E;
    float gate[3];
    { const int h = tid >> 6;
#pragma unroll
      for (int br = 0; br < 3; ++br) gate[br] = GATE[(size_t)m * 32 + (g * GQ + h) * 3 + br]; }
    const bf16* kcb = KCMP + (size_t)(b * NKV + g) * NCP * HD; const bf16* vcb = VCMPT + (size_t)(b * NKV + g) * HD * NCP;
    for (int i = tid; i < 4 * 512; i += 256) {
        const int h = i >> 9, n = i & 511; float s = -INFINITY;
        if (n < NCMP && 16 * n + 31 <= t) {
            const bf16* kr = kcb + (size_t)n * HD; float a = 0.f;
            for (int d = 0; d < 64; ++d) a += q[h][d] * bf2f(kr[d]);
            s = a - slope[h] * (float)(t - (16 * n + 31));
        }
        sc[h][n] = s;
    }
    __syncthreads();
    softmax4(&sc[0][0], 1024, 512, red);
    { const int h = tid >> 6, d = tid & 63; float a = 0.f;
      for (int n = 0; n < NCMP; ++n) { if (16 * n + 31 > t) break; a += sc[h][n] * bf2f(vcb[(size_t)d * NCP + (n & ~63) + kslot(n & 63)]); }
      oacc[h][d] += gate[0] * a; }
    if (tid < 128) {
        const int j = tid; float a = 0.f;
        for (int h = 0; h < 4; ++h)
            for (int n = 4 * j - 1; n <= 4 * j + 3; ++n) {
                if (n < 0 || n >= NCMP) continue;
                const int lo = max(16 * n, 64 * j), hi = min(16 * n + 32, 64 * j + 64);
                a += sc[h][n] * ((float)max(hi - lo, 0) / 32.0f);
            }
        if (64 * j > t) a = -INFINITY;
        if (j == 0 || j == t / 64) a = INFINITY;
        imp[j] = a;
    }
    __syncthreads();
    if (tid < 128) {
        const int j = tid; const float v = imp[j]; int rank = 0;
        for (int i = 0; i < 128; ++i) { const float u = imp[i]; rank += (u > v || (u == v && i < j)) ? 1 : 0; }
        if (rank < NTOP) sel[rank] = j;
    }
    __syncthreads();
    for (int i = tid; i < 4 * 1024; i += 256) {
        const int h = i >> 10, mm = i & 1023; const int pos = sel[mm >> 6] * 64 + (mm & 63); float s = -INFINITY;
        if (pos <= t) {
            const bf16* kr = KSKW + (size_t)(b * SEQ + pos) * 256 + g * HD; float a = 0.f;
            for (int d = 0; d < 64; ++d) a += q[h][d] * bf2f(kr[d]);
            s = a - slope[h] * (float)(t - pos);
        }
        sc[h][mm] = s;
    }
    __syncthreads();
    softmax4(&sc[0][0], 1024, 1024, red);
    { const int h = tid >> 6, d = tid & 63; float a = 0.f;
      for (int mm = 0; mm < 1024; ++mm) { const int blk = sel[mm >> 6], k = mm & 63; if (blk * 64 + k > t) continue;
          a += sc[h][mm] * bf2f(VST[((size_t)((b * NKV + g) * 128 + blk) * 64 + d) * 64 + kslot(k)]); }
      oacc[h][d] += gate[1] * a; }
    __syncthreads();
    for (int i = tid; i < 4 * 512; i += 256) {
        const int h = i >> 9, mm = i & 511; const int pos = t - 511 + mm; float s = -INFINITY;
        if (pos >= 0) {
            const bf16* kr = KSKW + (size_t)(b * SEQ + pos) * 256 + 128 + g * HD; float a = 0.f;
            for (int d = 0; d < 64; ++d) a += q[h][d] * bf2f(kr[d]);
            s = a - slope[h] * (float)(t - pos);
        }
        sc[h][mm] = s;
    }
    __syncthreads();
    softmax4(&sc[0][0], 1024, 512, red);
    { const int h = tid >> 6, d = tid & 63; float a = 0.f;
      for (int mm = 0; mm < 512; ++mm) { const int pos = t - 511 + mm; if (pos < 0) continue;
          a += sc[h][mm] * bf2f(VWT[((size_t)((b * NKV + g) * 128 + (pos >> 6)) * 64 + d) * 64 + kslot(pos & 63)]); }
      oacc[h][d] += gate[2] * a;
      out[(size_t)m * 512 + (g * GQ + h) * HD + d] = oacc[h][d]; }
}
__global__ void rms_bf16_k(const float* in, const float* g, bf16* MIXED) {
    const int w = (blockIdx.x * blockDim.x + threadIdx.x) >> 6, lane = threadIdx.x & 63;
    if (w >= M) return;
    const float* x = in + (size_t)w * 512; float v[8]; float s = 0.f;
#pragma unroll
    for (int i = 0; i < 8; ++i) { v[i] = x[8 * lane + i]; s += v[i] * v[i]; }
    const float r = 1.0f / sqrtf(wave_sum(s) * (1.0f / 512.0f) + EPS);
    v4u o;
#pragma unroll
    for (int i = 0; i < 4; ++i) o[i] = pk2(v[2 * i] * r * g[8 * lane + 2 * i], v[2 * i + 1] * r * g[8 * lane + 2 * i + 1]);
    *(v4u*)(MIXED + (size_t)w * 1024 + 512 + 8 * lane) = o;
}
}

namespace cmp {
using f32x16 = __attribute__((ext_vector_type(16))) float;
constexpr int L_X = 0, X_ROWS = 544, L_G = X_ROWS * 128, G_LD = 528  , L_END = L_G + 32 * G_LD;
static_assert(L_END <= RING_BYTES, "cmp LDS map");
struct Ctx { const bf16* KCVC; const bf16 *W1K, *W1V, *W2K, *W2V; const float* C1P; bf16* KCMP; bf16* VCMPT; };
__device__ __forceinline__ float gelu_tanh(float v) {
    const float u = 0.7978845608028654f * (v + 0.044715f * v * v * v);
    return v * __builtin_amdgcn_rcpf(1.0f + __builtin_amdgcn_exp2f(-2.0f * LOG2E * u));
}
__device__ __forceinline__ void cmp_unit(const Ctx& C, LAS unsigned char* lds, int u) {
    const int tid = threadIdx.x, lane = tid & 63, wave = __builtin_amdgcn_readfirstlane(tid >> 6), r32 = lane & 31, hi = lane >> 5;
    const int rt = u & 15, g = (u >> 4) & 1, b = (u >> 5) & 1, kv = u >> 6; const int n0 = 32 * rt;
    { const bf16* src = C.KCVC + ((size_t)b * SEQ + 16 * n0) * 256 + kv * 128 + g * 64;
      for (int q = tid; q < 528 * 8; q += 512) { const int tok = q >> 3, c8 = q & 7; const v4u v = *(const GAS v4u*)(src + (size_t)tok * 256 + c8 * 8);
          const int rho = (tok & 15) * 34 + (tok >> 4); *(LAS v4u*)(lds + L_X + rho * 128 + ((c8 ^ ((rho >> 1) & 7)) << 4)) = v; } }
    __syncthreads();
    f32x16 acc;
#pragma unroll
    for (int i = 0; i < 16; ++i) acc[i] = 0.f;
    const bf16* wrow = (kv ? C.W1V : C.W1K) + (size_t)(32 * wave + r32) * CMPK + 8 * hi;
#pragma unroll 1
    for (int l = 0; l < 32; ++l) {
        const int rho = (l & 15) * 34 + r32 + (l >> 4); const int swz = (rho >> 1) & 7; LAS const unsigned char* xr = lds + L_X + rho * 128;
#pragma unroll
        for (int dq = 0; dq < 4; ++dq) {
            const bf16x8 a = *(const LAS bf16x8*)(xr + (((2 * dq + hi) ^ swz) << 4));
            const bf16x8 bw = *(const GAS bf16x8*)(wrow + l * 64 + dq * 16);
            acc = __builtin_amdgcn_mfma_f32_32x32x16_bf16(a, bw, acc, 0, 0, 0);
        }
    }
    { const int col = 32 * wave + r32; float c1 = 0.f;
#pragma unroll
      for (int j = 0; j < 16; ++j) c1 += C.C1P[(kv * 16 + j) * 256 + col];
#pragma unroll
      for (int i = 0; i < 16; ++i) { const int n = (i & 3) + 8 * (i >> 2) + 4 * hi; *(LAS bf16*)(lds + L_G + n * G_LD + col * 2) = (bf16)f2bf(gelu_tanh(acc[i] + c1)); } }
    __syncthreads();
    if (wave < 2) {
        f32x16 o;
#pragma unroll
        for (int i = 0; i < 16; ++i) o[i] = 0.f;
        const bf16* w2 = (kv ? C.W2V : C.W2K) + (size_t)(32 * wave + r32) * CMPH + 8 * hi;
#pragma unroll 4
        for (int s = 0; s < 16; ++s) {
            const bf16x8 a = *(const LAS bf16x8*)(lds + L_G + r32 * G_LD + (16 * s + 8 * hi) * 2);
            const bf16x8 bw = *(const GAS bf16x8*)(w2 + 16 * s);
            o = __builtin_amdgcn_mfma_f32_32x32x16_bf16(a, bw, o, 0, 0, 0);
        }
        const int d = 32 * wave + r32;
        if (kv == 0) { bf16* dst = C.KCMP + ((size_t)(b * NKV + g) * NCP + n0) * HD + d;
#pragma unroll
            for (int i = 0; i < 16; ++i) { const int n = (i & 3) + 8 * (i >> 2) + 4 * hi; dst[(size_t)n * HD] = (n0 + n < NCMP) ? (bf16)f2bf(o[i]) : (bf16)0; } }
        else { bf16* dst = C.VCMPT + ((size_t)(b * NKV + g) * HD + d) * NCP + n0;
#pragma unroll
            for (int hf = 0; hf < 2; ++hf) { float v[8];
#pragma unroll
                for (int j = 0; j < 8; ++j) { const int i = 8 * hf + j; const int n = (i & 3) + 8 * (i >> 2) + 4 * hi; v[j] = (n0 + n < NCMP) ? o[i] : 0.f; }
                v4u w; w.x = pk2(v[0], v[1]); w.y = pk2(v[2], v[3]); w.z = pk2(v[4], v[5]); w.w = pk2(v[6], v[7]);
                *(GAS v4u*)(dst + 16 * hf + 8 * hi) = w; } }
    }
    __syncthreads();
}
}

namespace nsa {
using f32x16 = __attribute__((ext_vector_type(16))) float;
typedef float f32x2_t __attribute__((ext_vector_type(2))); typedef __bf16 bf16x2_t __attribute__((ext_vector_type(2)));
__device__ __forceinline__ unsigned cvtpk(float lo, float hi) { f32x2_t v = {lo, hi}; bf16x2_t b = __builtin_convertvector(v, bf16x2_t); return __builtin_bit_cast(unsigned, b); }
constexpr int L_KV = 0, L_IMP = 65536, IMP_LD = 132, L_SELM = L_IMP + 64 * IMP_LD * 4, L_UNION = L_SELM + 1024, L_SSQ = L_UNION + 64, L_END = L_SSQ + 128;
constexpr int OUTS_LD = 520;
static_assert(L_END <= RING_BYTES && 32 * OUTS_LD * 2 <= 65536, "nsa LDS map");

__device__ __forceinline__ float half_max(float m) { auto rr = __builtin_amdgcn_permlane32_swap(__float_as_uint(m), __float_as_uint(m), false, false); return fmaxf(__uint_as_float(rr[0]), __uint_as_float(rr[1])); }
__device__ __forceinline__ float half_sum(float m) { auto rr = __builtin_amdgcn_permlane32_swap(__float_as_uint(m), __float_as_uint(m), false, false); return __uint_as_float(rr[0]) + __uint_as_float(rr[1]); }

template <bool HASV> __device__ __forceinline__ void stage_dma(LAS unsigned char* kb, const bf16* k, int ks, const bf16* v, int vs, int wg, int lane) {
#pragma unroll
    for (int i = 0; i < 2; ++i) { const int row = 16 * wg + 8 * i + (lane >> 3), c8 = (lane & 7) ^ ((row >> 1) & 7);
        __builtin_amdgcn_global_load_lds((const GAS unsigned*)(k + (size_t)row * ks + c8 * 8), (LAS unsigned*)(kb + (16 * wg + 8 * i) * 128), 16, 0, 0);
        if (HASV) __builtin_amdgcn_global_load_lds((const GAS unsigned*)(v + (size_t)row * vs + c8 * 8), (LAS unsigned*)(kb + 8192 + (16 * wg + 8 * i) * 128), 16, 0, 0); }
}

template <bool DO_PV, bool DO_IMP>
__device__ __forceinline__ void step32(LAS const unsigned char* kb, int kt, const bf16x8 (&qf)[4], const int (&off)[4], float sl, float b0, int klo, int rng, bool need_mask,
                                       float& m, float& l, f32x16 (&O)[2], int hi, LAS float* improw, int jb, float invl, bool impw) {
    f32x16 p;
#pragma unroll
    for (int i = 0; i < 16; ++i) p[i] = 0.f;
#pragma unroll
    for (int s = 0; s < 4; ++s) { const bf16x8 k0 = *(const LAS bf16x8*)(kb + kt * 4096 + off[s]); p = __builtin_amdgcn_mfma_f32_32x32x16_bf16(k0, qf[s], p, 0, 0, 0); }
    const float NEG = -INFINITY;
    float rm = NEG;
#pragma unroll
    for (int i = 0; i < 16; ++i) {
        const int c = (i & 3) + 8 * (i >> 2) + 32 * kt;
        float a = fmaf(sl, (float)c, p[i]);
        if (need_mask) { if ((unsigned)(c + 4 * hi - klo) > (unsigned)rng) a = NEG; }
        p[i] = a; rm = fmaxf(rm, a);
    }
    const float sl4 = sl * (float)(4 * hi);
    rm = half_max(rm + sl4);
    const float mn = fmaxf(m, rm + b0);
    if (__any(mn > m)) {
        const float alpha = __builtin_amdgcn_exp2f(m - mn);
        l *= alpha;
        if (DO_PV) {
#pragma unroll
            for (int i = 0; i < 16; ++i) { O[0][i] *= alpha; O[1][i] *= alpha; }
        }
        m = mn;
    }
    const float mb = m - b0 - sl4;
    float ps = 0.f;
#pragma unroll
    for (int i = 0; i < 16; ++i) { p[i] = __builtin_amdgcn_exp2f(p[i] - mb); ps += p[i]; }
    l += ps;
    if (DO_IMP) {
#pragma unroll
        for (int gq = 0; gq < 4; ++gq) {
            float bb = 0.5f * p[4 * gq + 3] * invl; float aa = (p[4 * gq] + p[4 * gq + 1] + p[4 * gq + 2]) * invl + bb;
            aa += __shfl_xor(aa, 1); aa += __shfl_xor(aa, 2); bb += __shfl_xor(bb, 1); bb += __shfl_xor(bb, 2);
            if (impw) { const int j = jb + 8 * kt + 2 * gq + hi; (void)__hip_atomic_fetch_add(improw + j, aa, __ATOMIC_RELAXED, __HIP_MEMORY_SCOPE_WORKGROUP); (void)__hip_atomic_fetch_add(improw + j + 1, bb, __ATOMIC_RELAXED, __HIP_MEMORY_SCOPE_WORKGROUP); }
        }
    }
    if (DO_PV) {
#pragma unroll
        for (int k2 = 0; k2 < 2; ++k2) {
            v4u pw;
#pragma unroll
            for (int j = 0; j < 4; ++j) pw[j] = cvtpk(p[8 * k2 + 2 * j], p[8 * k2 + 2 * j + 1]);
            const bf16x8 pf = __builtin_bit_cast(bf16x8, pw);
            const bf16x8 v0 = *(const LAS bf16x8*)(kb + 8192 + off[2 * kt + k2]);
            const bf16x8 v1 = *(const LAS bf16x8*)(kb + 8192 + 4096 + off[2 * kt + k2]);
            O[0] = __builtin_amdgcn_mfma_f32_32x32x16_bf16(v0, pf, O[0], 0, 0, 0);
            O[1] = __builtin_amdgcn_mfma_f32_32x32x16_bf16(v1, pf, O[1], 0, 0, 0);
        }
    }
}

enum { MODE_CMP1 = 0, MODE_CMP2 = 1, MODE_SEL = 2, MODE_WIN = 3 };
struct Ctx {
    const bf16 *Q, *KCMP, *VCMPT, *KSKW, *VST, *VWT; const float* GATE; const float* gn; bf16* MIXED;
};

__device__ __forceinline__ void nsa_unit(const Ctx& C, LAS unsigned char* lds, int b, int t0) {
    const int tid = threadIdx.x, lane = tid & 63, wave = __builtin_amdgcn_readfirstlane(tid >> 6), g = wave >> 2, gtid = tid & 255;
    const int r32 = lane & 31, hi = lane >> 5, qq = r32 >> 2, hq = r32 & 3;
    const int tq = 8 * (wave & 3) + qq, t = t0 + tq, hh = g * 4 + hq;
    const size_t mrow = (size_t)b * SEQ + t;
    const float slope2 = __builtin_amdgcn_exp2f(-(float)(hh + 1)) * LOG2E;
    LAS unsigned char* kv = lds + L_KV + g * 32768;
    LAS float* IMP = (LAS float*)(lds + L_IMP);
    LAS unsigned* SELM = (LAS unsigned*)(lds + L_SELM);
    LAS unsigned* UNI = (LAS unsigned*)(lds + L_UNION);
    LAS float* SSQ = (LAS float*)(lds + L_SSQ);
    int off[4];
#pragma unroll
    for (int s = 0; s < 4; ++s) off[s] = r32 * 128 + (((2 * s + hi) ^ ((r32 >> 1) & 7)) << 4);
    bf16x8 qf[4];
    { const bf16* qp = C.Q + mrow * 512 + hh * 64 + 8 * hi;
#pragma unroll
      for (int s = 0; s < 4; ++s) qf[s] = *(const GAS bf16x8*)(qp + 16 * s); }
    float gate[3];
#pragma unroll
    for (int br = 0; br < 3; ++br) gate[br] = C.GATE[mrow * 32 + hh * 3 + br];
    for (int i = tid; i < 64 * IMP_LD; i += 512) IMP[i] = 0.f;
    if (tid < 32) SSQ[tid] = 0.f;
    if (tid < 8) UNI[tid] = 0u;
    f32x16 OT[2];
#pragma unroll
    for (int i = 0; i < 16; ++i) { OT[0][i] = 0.f; OT[1][i] = 0.f; }
    const int pair = g * 32 + tq;
    LAS float* improw = IMP + pair * IMP_LD;

    const bf16* kcb = C.KCMP + (size_t)(b * NKV + g) * NCP * HD; const bf16* vcb = C.VCMPT + (size_t)(b * NKV + g) * HD * NCP;
    const bf16* ksb = C.KSKW + (size_t)b * SEQ * 256 + g * 64; const bf16* kwb = ksb + 128;
    const bf16* vsb = C.VST + (size_t)(b * NKV + g) * 128 * 4096; const bf16* vwb = C.VWT + (size_t)(b * NKV + g) * 128 * 4096;
    const int nlim = (t >= 31) ? ((t - 31) >> 4) : -1;
    const int ntc = (t0 >> 10) + 1;
    const int jcur = t0 >> 6;
    unsigned selw[4] = {0u, 0u, 0u, 0u};
    float m_c = -1e30f, invl_c = 0.f;

#define NSA_BRANCH(MODE, TRIPS, NEXT_EXPR, KPTR, KSTR, VPTR, VSTR, MASKCODE, GATEV)                                                                  \
    {                                                                                                                                                \
        constexpr bool HASV = (MODE != MODE_CMP1);                                                                                                   \
        float m_ = (MODE == MODE_CMP2) ? m_c : -1e30f, l_ = 0.f; f32x16 O[2];                                                                        \
        _Pragma("unroll") for (int i = 0; i < 16; ++i) { O[0][i] = 0.f; O[1][i] = 0.f; }                                                             \
        const int trips_ = (TRIPS); int it_ = 0; int cur_ = -1, nxt_ = -1, ni_ = 0;                                                                  \
        if (trips_ > 0) { NEXT_EXPR; }                                                                                                               \
        if (nxt_ >= 0) { const int x = nxt_; stage_dma<HASV>(kv, KPTR, KSTR, VPTR, VSTR, wave & 3, lane); }                                           \
        asm volatile("s_waitcnt vmcnt(0)" ::: "memory"); __syncthreads();                                                                            \
        for (; it_ < trips_; ++it_) {                                                                                                                \
            cur_ = nxt_; ni_ = it_ + 1; if (ni_ < trips_) { NEXT_EXPR; } else nxt_ = -1;                                                             \
            if (nxt_ >= 0) { const int x = nxt_; stage_dma<HASV>(kv + (ni_ & 1) * 16384, KPTR, KSTR, VPTR, VSTR, wave & 3, lane); }                   \
            if (cur_ >= 0) { const int x = cur_; float sl, b0; int klo, khi; MASKCODE;                                                               \
                int rng = khi - klo; if (rng < 0) { klo = 1 << 20; rng = 0; }                                                                        \
                const bool skip = (MODE == MODE_SEL) && !__any(klo == 0);                                                                            \
                if (!skip) { const bool nm = __any(klo > 0 || rng < 63); LAS const unsigned char* kb_ = kv + (it_ & 1) * 16384;                      \
                    step32<HASV, MODE == MODE_CMP2>(kb_, 0, qf, off, sl, b0, klo, rng, nm, m_, l_, O, hi, improw, 16 * x, invl_c, hq == 0); \
                    step32<HASV, MODE == MODE_CMP2>(kb_, 1, qf, off, sl, b0, klo, rng, nm, m_, l_, O, hi, improw, 16 * x, invl_c, hq == 0); } } \
            asm volatile("s_waitcnt vmcnt(0)" ::: "memory"); __syncthreads();                                                                        \
        }                                                                                                                                            \
        const float lt = half_sum(l_);                                                                                                               \
        if (MODE == MODE_CMP1) { m_c = m_; invl_c = lt > 0.f ? 1.0f / lt : 0.f; }                                                                    \
        else { const float sc = (lt > 0.f) ? (GATEV) / lt : 0.f;                                                                                     \
            _Pragma("unroll") for (int i = 0; i < 16; ++i) { OT[0][i] += sc * O[0][i]; OT[1][i] += sc * O[1][i]; } }                                 \
    }

#define CMP_MASK sl = 16.0f * slope2; b0 = slope2 * (float)(1024 * x + 31 - t); klo = 0; khi = min(63, nlim - 64 * x);
    NSA_BRANCH(MODE_CMP1, ntc, nxt_ = ntc - 1 - ni_, kcb + (size_t)x * 64 * 64, 64, vcb + x * 64, NCP, CMP_MASK, 0.f)
    NSA_BRANCH(MODE_CMP2, ntc, nxt_ = ntc - 1 - ni_, kcb + (size_t)x * 64 * 64, 64, vcb + x * 64, NCP, CMP_MASK, gate[0])
#undef CMP_MASK
    {
        const int pr = tid >> 3, sub = tid & 7; const int tqq = t0 + (pr & 31);
        const LAS float* row = IMP + pr * IMP_LD + sub * 16;
        unsigned key[16]; unsigned validm = 0u;
#pragma unroll
        for (int k = 0; k < 16; ++k) { const int j = sub * 16 + k; unsigned bits = __float_as_uint(row[k]);
            if (j == 0 || j == (tqq >> 6)) bits = 0x7f800000u;
            const bool valid = (64 * j <= tqq);
            key[k] = valid ? ((bits & 0xffffff80u) | (unsigned)(127 - j)) : 0u; validm |= (valid ? 1u : 0u) << k; }
        unsigned T = 0u;
        for (int bit = 30; bit >= 0; --bit) { const unsigned cand = T | (1u << bit); int cnt = 0;
#pragma unroll
            for (int k = 0; k < 16; ++k) cnt += (key[k] >= cand) ? 1 : 0;
            cnt += __shfl_xor(cnt, 1); cnt += __shfl_xor(cnt, 2); cnt += __shfl_xor(cnt, 4);
            if (cnt >= NTOP) T = cand; }
        unsigned sm = 0u;
#pragma unroll
        for (int k = 0; k < 16; ++k) sm |= ((key[k] >= T) ? 1u : 0u) << k;
        sm &= validm;
        ((LAS unsigned short*)SELM)[pr * 8 + sub] = (unsigned short)sm;
        (void)__hip_atomic_fetch_or(UNI + (pr >> 5) * 4 + (sub >> 1), sm << (16 * (sub & 1)), __ATOMIC_RELAXED, __HIP_MEMORY_SCOPE_WORKGROUP);
    }
    __syncthreads();
    {
#pragma unroll
        for (int w = 0; w < 4; ++w) selw[w] = SELM[pair * 4 + w];
        unsigned u0[4], u1[4];
#pragma unroll
        for (int w = 0; w < 4; ++w) { u0[w] = (unsigned)__builtin_amdgcn_readfirstlane(UNI[w]); u1[w] = (unsigned)__builtin_amdgcn_readfirstlane(UNI[4 + w]); }
        const int c0 = __builtin_popcount(u0[0]) + __builtin_popcount(u0[1]) + __builtin_popcount(u0[2]) + __builtin_popcount(u0[3]);
        const int c1 = __builtin_popcount(u1[0]) + __builtin_popcount(u1[1]) + __builtin_popcount(u1[2]) + __builtin_popcount(u1[3]);
        unsigned mw[4];
#pragma unroll
        for (int w = 0; w < 4; ++w) mw[w] = g ? u1[w] : u0[w];
#define SEL_NEXT { if (mw[3]) { const int bq = 31 - __builtin_clz(mw[3]); mw[3] &= ~(1u << bq); nxt_ = 96 + bq; } else if (mw[2]) { const int bq = 31 - __builtin_clz(mw[2]); mw[2] &= ~(1u << bq); nxt_ = 64 + bq; } \
            else if (mw[1]) { const int bq = 31 - __builtin_clz(mw[1]); mw[1] &= ~(1u << bq); nxt_ = 32 + bq; } else if (mw[0]) { const int bq = 31 - __builtin_clz(mw[0]); mw[0] &= ~(1u << bq); nxt_ = bq; } else nxt_ = -1; }
#define SEL_MASK sl = slope2; b0 = slope2 * (float)(64 * x - t); { const unsigned wsel = (x < 32) ? selw[0] : (x < 64) ? selw[1] : (x < 96) ? selw[2] : selw[3]; \
            const bool fl = (wsel >> (x & 31)) & 1u; klo = 0; khi = fl ? ((x == (t >> 6)) ? (t & 63) : 63) : -1; }
        NSA_BRANCH(MODE_SEL, max(c0, c1), SEL_NEXT, ksb + (size_t)x * 64 * 256, 256, vsb + (size_t)x * 4096, 64, SEL_MASK, gate[1])
#undef SEL_NEXT
#undef SEL_MASK
    }
    {
        const int nwin = min(9, jcur + 1);
#define WIN_MASK sl = slope2; b0 = slope2 * (float)(64 * x - t); klo = max(0, t - 511 - 64 * x); khi = min(63, t - 64 * x);
        NSA_BRANCH(MODE_WIN, nwin, nxt_ = jcur - ni_, kwb + (size_t)x * 64 * 256, 256, vwb + (size_t)x * 4096, 64, WIN_MASK, gate[2])
#undef WIN_MASK
    }
#undef NSA_BRANCH
    {
        float ss = 0.f;
#pragma unroll
        for (int i = 0; i < 16; ++i) ss += OT[0][i] * OT[0][i] + OT[1][i] * OT[1][i];
        ss += __shfl_xor(ss, 1); ss += __shfl_xor(ss, 2); ss = half_sum(ss);
        if (hq == 0 && hi == 0) (void)__hip_atomic_fetch_add(SSQ + tq, ss, __ATOMIC_RELAXED, __HIP_MEMORY_SCOPE_WORKGROUP);
        __syncthreads();
        const float r = 1.0f / sqrtf(SSQ[tq] * (1.0f / 512.0f) + EPS);
        LAS bf16* outs = (LAS bf16*)(lds + L_KV);
#pragma unroll
        for (int d0 = 0; d0 < 2; ++d0)
#pragma unroll
            for (int gq = 0; gq < 4; ++gq) { v2u w; w.x = cvtpk(OT[d0][4 * gq] * r, OT[d0][4 * gq + 1] * r); w.y = cvtpk(OT[d0][4 * gq + 2] * r, OT[d0][4 * gq + 3] * r);
                *(LAS v2u*)(outs + tq * OUTS_LD + hh * 64 + 32 * d0 + 8 * gq + 4 * hi) = w; }
        __syncthreads();
#pragma unroll
        for (int i = 0; i < 4; ++i) { const int id = tid + 512 * i, row = id >> 6, c = id & 63;
            const v4u v = *(const LAS v4u*)(outs + row * OUTS_LD + 8 * c); const f32x4 g0 = *(const GAS f32x4*)(C.gn + 8 * c), g1 = *(const GAS f32x4*)(C.gn + 8 * c + 4);
            v4u o; o.x = pk2(bflo(v.x) * g0[0], bfhi(v.x) * g0[1]); o.y = pk2(bflo(v.y) * g0[2], bfhi(v.y) * g0[3]); o.z = pk2(bflo(v.z) * g1[0], bfhi(v.z) * g1[1]); o.w = pk2(bflo(v.w) * g1[2], bfhi(v.w) * g1[3]);
            *(GAS v4u*)(C.MIXED + ((size_t)b * SEQ + t0 + row) * 1024 + 512 + 8 * c) = o; }
        __syncthreads();
    }
}
__device__ __forceinline__ void nsa_phase(const Ctx& C, LAS unsigned char* lds, int vcu, int G) {
    constexpr int NU = BATCH * (SEQ / 32);
    if (G == 256) { for (int i = 0; i < 2; ++i) { const int u = i ? (NU - 1 - vcu) : vcu; nsa_unit(C, lds, u >> 8, (u & 255) * 32); } }
    else for (int u = vcu; u < NU; u += G) nsa_unit(C, lds, u >> 8, (u & 255) * 32);
}
}

#ifndef MK_FUSED
#define MK_FUSED 0
#endif
#ifndef MK_SLOW_CMP
#define MK_SLOW_CMP 1
#endif
#ifndef MK_SLOW_NSA
#define MK_SLOW_NSA 1
#endif
constexpr int N_PHASES = 8;
struct Args { const float* in[18]; float* out; unsigned char* ws; int ph_lo, ph_hi; };
__global__ void __launch_bounds__(NWAVES * 64, 2) mega_fwd(Args args) {
    extern __shared__ __attribute__((aligned(16))) unsigned char lds[];
    Frame F;
    F.lds = (LAS unsigned char*)lds;
    F.MISC = (volatile LAS unsigned*)(F.lds + MISC_OFF);
    F.tid = threadIdx.x; F.lane = F.tid & 63; F.wave = __builtin_amdgcn_readfirstlane(F.tid >> 6);
    F.G = gridDim.x; { const int bx = blockIdx.x; F.vcu = (F.G % 8 == 0) ? (bx % 8) * (F.G / 8) + bx / 8 : bx; }
    F.ws = args.ws; F.out = args.out; F.ctl = (gu32*)(args.ws + WS_CTL);
#pragma unroll
    for (int i = 0; i < 18; ++i) F.in[i] = args.in[i];
    for (int u = F.tid; u < (LDS_BYTES - LDSCTL_OFF) / 4; u += NWAVES * 64) ((LAS unsigned*)(F.lds + LDSCTL_OFF))[u] = 0u;
    __syncthreads();
    XcdBarrier bar; bar.bar = (unsigned*)(F.ctl + CW_BAR); bar.x = 0; bar.st = nullptr;
    const int lo = args.ph_lo, hi = args.ph_hi;
    if (hi - lo > 1) bar = xcd_barrier_post((unsigned*)(F.ctl + CW_BAR), F.MISC + 8);
#define IN(k) (lo <= (k) && (k) < hi)
#define BOTH(k) (IN(k) && IN((k) + 1))
#define GRID_BAR() xcd_barrier(bar)
    unsigned char* ws = args.ws;
    pg8::bf16_t* XN = (pg8::bf16_t*)(ws + WS_XN);
    const int gw = F.vcu * NWAVES + F.wave, NGW = F.G * NWAVES;

#ifndef MK_P3_ONLY
    if (IN(0)) { p0_prologue(F); if (BOTH(0)) GRID_BAR(); }

    if (IN(1)) {
        pg8::Gemm g{XN, (const pg8::bf16_t*)(ws + WS_WIN), M, NPROJ, DM};
        { pg8::OrderInA S; S.S.init(M, 11 * 256, F.G, (int)blockIdx.x);
          pg8::EpiInProj E{(pg8::bf16_t*)(ws + WS_CB), (pg8::bf16_t*)(ws + WS_U), (pg8::bf16_t*)(ws + WS_Q), (pg8::bf16_t*)(ws + WS_KCVC), (pg8::bf16_t*)(ws + WS_KSKW), (float*)(ws + WS_GATE)};
          pg8::gemm_phase<pg8::EpiInProj, pg8::OrderInA, true, true, false>(F.lds + RING_OFF, g, S, E); }
        { pg8::OrderInB S{F.G, (int)blockIdx.x};
          pg8::EpiVT E{(pg8::bf16_t*)(ws + WS_VST), (pg8::bf16_t*)(ws + WS_VWT)};
          pg8::gemm_phase<pg8::EpiVT, pg8::OrderInB, false, true, true>(F.lds + RING_OFF, g, S, E); }
        if (BOTH(1)) GRID_BAR();
    }

    if (IN(2)) {
#if MK_SLOW_CMP
        for (int m = gw; m < M; m += NGW) conv_token((const bf16*)(ws + WS_CB), (const bf16*)(ws + WS_U), F.in[3], F.in[10], (bf16*)(ws + WS_MIXED), m, F.lane);
#else
        const cmp::Ctx CC{(const bf16*)(ws + WS_KCVC), (const bf16*)(ws + WS_CW1K), (const bf16*)(ws + WS_CW1V), (const bf16*)(ws + WS_CW2K), (const bf16*)(ws + WS_CW2V), (const float*)(ws + WS_C1P),
                          (bf16*)(ws + WS_KCMP), (bf16*)(ws + WS_VCMPT)};
        if (F.G == 256) {
            const int bx = blockIdx.x, idx = (bx >> 4) * 8 + (bx & 7);
            if (((bx >> 3) & 1) == 0) cmp::cmp_unit(CC, F.lds + RING_OFF, idx);
            else for (int m = idx * NWAVES + F.wave; m < M; m += 128 * NWAVES) conv_token((const bf16*)(ws + WS_CB), (const bf16*)(ws + WS_U), F.in[3], F.in[10], (bf16*)(ws + WS_MIXED), m, F.lane);
        } else {
            for (int u = F.vcu; u < 128; u += F.G) cmp::cmp_unit(CC, F.lds + RING_OFF, u);
            for (int m = gw; m < M; m += NGW) conv_token((const bf16*)(ws + WS_CB), (const bf16*)(ws + WS_U), F.in[3], F.in[10], (bf16*)(ws + WS_MIXED), m, F.lane);
        }
#endif
        if (BOTH(2)) GRID_BAR();
    }

#endif
    if (IN(3)) {
#if !MK_SLOW_NSA
        const nsa::Ctx C{(const bf16*)(ws + WS_Q), (const bf16*)(ws + WS_KCMP), (const bf16*)(ws + WS_VCMPT), (const bf16*)(ws + WS_KSKW), (const bf16*)(ws + WS_VST), (const bf16*)(ws + WS_VWT),
                         (const float*)(ws + WS_GATE), F.in[11], (bf16*)(ws + WS_MIXED)};
        nsa::nsa_phase(C, F.lds + RING_OFF, F.vcu, F.G);
#endif
        if (BOTH(3)) GRID_BAR();
    }

#ifndef MK_P3_ONLY
    if (IN(4)) {
        pg8::Gemm g{(const pg8::bf16_t*)(ws + WS_MIXED), (const pg8::bf16_t*)(ws + WS_WOUT), M, DM, DM};
        pg8::StaticOrder S; S.init(M, DM, F.G, (int)blockIdx.x);
        pg8::EpiOutProj E{F.in[0], F.out, XN, (float*)(ws + WS_SSQ1)};
        pg8::gemm_phase<pg8::EpiOutProj, pg8::StaticOrder, false, true, false>(F.lds + RING_OFF, g, S, E);
        if (BOTH(4)) GRID_BAR();
    }

    if (IN(5)) {
        pg8::Gemm g{XN, (const pg8::bf16_t*)(ws + WS_WGU), M, 2 * DFF, DM};
        pg8::StaticOrder S; S.init(M, 2 * DFF, F.G, (int)blockIdx.x);
        pg8::EpiSwiGLU E{(const float*)(ws + WS_SSQ1), (pg8::bf16_t*)(ws + WS_ACT)};
        pg8::gemm_phase<pg8::EpiSwiGLU, pg8::StaticOrder, true, true, false>(F.lds + RING_OFF, g, S, E);
        if (BOTH(5)) GRID_BAR();
    }

    if (IN(6)) {
        pg8::Gemm g{(const pg8::bf16_t*)(ws + WS_ACT), (const pg8::bf16_t*)(ws + WS_WDN), M, DM, DFF};
        pg8::StaticOrder S; S.init(M, DM, F.G, (int)blockIdx.x);
        pg8::EpiDown E{F.out, (float*)(ws + WS_SSQ2)};
        pg8::gemm_phase<pg8::EpiDown, pg8::StaticOrder, false, true, false>(F.lds + RING_OFF, g, S, E);
        if (BOTH(6)) GRID_BAR();
    }

    if (IN(7)) {
        for (int m = gw; m < M; m += NGW) final_row(F.out, (const float*)(ws + WS_SSQ2), F.in[17], F.out, m, F.lane);
    }
#endif
#undef IN
#undef BOTH
#undef GRID_BAR
}

extern "C" void kernel_launch(void* const* d_in, const int* in_sizes, int n_in, void* d_out, int out_size, void* d_ws, size_t ws_size, hipStream_t stream) {
    static int grid = 0;
    if (grid == 0) {
        if (n_in != 18 || in_sizes[0] != M * DM || out_size != M * DM || ws_size < WS_END) { fprintf(stderr, "kernel_launch: unexpected shapes (n_in %d, in0 %d, out %d, ws %zu); nothing launched\n", n_in, n_in > 0 ? in_sizes[0] : -1, out_size, ws_size); grid = -1; return; }
        int dev = 0, cus = 0, per_cu = 0;
        if (hipGetDevice(&dev) != hipSuccess || hipDeviceGetAttribute(&cus, hipDeviceAttributeMultiprocessorCount, dev) != hipSuccess) { grid = -1; return; }
        if (hipFuncSetAttribute((const void*)mega_fwd, hipFuncAttributeMaxDynamicSharedMemorySize, LDS_BYTES) != hipSuccess) { fprintf(stderr, "kernel_launch: hipFuncSetAttribute failed\n"); grid = -1; return; }
        if (hipOccupancyMaxActiveBlocksPerMultiprocessor(&per_cu, (const void*)mega_fwd, NWAVES * 64, LDS_BYTES) != hipSuccess || per_cu < 1)
            fprintf(stderr, "kernel_launch: note: occupancy query reports %d workgroups per CU\n", per_cu);
        (void)hipGetLastError();
        grid = cus;
    }
    if (grid < 0) return;
    unsigned char* ws = (unsigned char*)d_ws;
    if (hipMemsetAsync(ws + WS_CTL, 0, CTL_ZERO_BYTES, stream) != hipSuccess) { fprintf(stderr, "kernel_launch: memset failed\n"); return; }
    Args a{};
    for (int i = 0; i < 18; ++i) a.in[i] = (const float*)d_in[i];
    a.out = (float*)d_out; a.ws = ws;
#define LAUNCH(lo_, hi_) do { a.ph_lo = (lo_); a.ph_hi = (hi_); hipLaunchKernelGGL(mega_fwd, dim3(grid), dim3(NWAVES * 64), LDS_BYTES, stream, a); } while (0)
#if MK_FUSED
    LAUNCH(0, N_PHASES);
#else
    LAUNCH(0, 1); LAUNCH(1, 2); LAUNCH(2, 3);
#if MK_SLOW_CMP
    {
        const int R = BATCH * NCMP * NKV;
        float* ACMP = (float*)(ws + WS_ACMP); float* HID = (float*)(ws + WS_HID); float* COUT = (float*)(ws + WS_COUT);
        for (int kv = 0; kv < 2; ++kv) {
            slow::cmp_gather_k<<<(unsigned)(((size_t)R * CMPK + 255) / 256), 256, 0, stream>>>((const bf16*)(ws + WS_KCVC), kv ? 128 : 0, (const float*)d_in[kv ? 7 : 4], ACMP);
            slow::gemm_f32<1><<<dim3(CMPH / 64, (R + 63) / 64), 256, 0, stream>>>(ACMP, CMPK, (const float*)d_in[kv ? 8 : 5], CMPH, HID, CMPH, R, CMPH, CMPK);
            slow::gemm_f32<0><<<dim3(1, (R + 63) / 64), 256, 0, stream>>>(HID, CMPH, (const float*)d_in[kv ? 9 : 6], HD, COUT, HD, R, HD, CMPH);
            slow::cmp_pack_k<<<(BATCH * NKV * NCP * HD + 255) / 256, 256, 0, stream>>>(COUT, kv, (bf16*)(ws + (kv ? WS_VCMPT : WS_KCMP)));
        }
    }
#endif
#if MK_SLOW_NSA
    slow::nsa_k<<<M * NKV, 256, 0, stream>>>((const bf16*)(ws + WS_Q), (const bf16*)(ws + WS_KCMP), (const bf16*)(ws + WS_VCMPT), (const bf16*)(ws + WS_KSKW), (const bf16*)(ws + WS_VST), (const bf16*)(ws + WS_VWT),
                                            (const float*)(ws + WS_GATE), (float*)(ws + WS_NSAOUT));
    slow::rms_bf16_k<<<M / 4, 256, 0, stream>>>((const float*)(ws + WS_NSAOUT), (const float*)d_in[11], (bf16*)(ws + WS_MIXED));
#else
    LAUNCH(3, 4);
#endif
    LAUNCH(4, 5); LAUNCH(5, 6); LAUNCH(6, 7); LAUNCH(7, 8);
#endif
    const hipError_t le = hipPeekAtLastError();
    if (le != hipSuccess) fprintf(stderr, "kernel_launch: launch failed: %s\n", hipGetErrorName(le));
}
```

```cpp
#include <hip/hip_runtime.h>
#include <cstdio>
#include <cstdint>
#include <cmath>
#define MK_SLOW_NSA 0
#define MK_SLOW_CMP 0
#define MK_FUSED 1
namespace pg8 {
#define PG8_LAS __attribute__((address_space(3)))
typedef unsigned short bf16_t;
typedef short bf16x8 __attribute__((ext_vector_type(8)));
typedef float f32x4 __attribute__((ext_vector_type(4)));
typedef unsigned u32x4 __attribute__((ext_vector_type(4)));
constexpr int BM = 256, BK = 64, HALF = 128, HTB = HALF * BK * 2  , STAGE_BYTES = 8 * HTB, NXCD = 8, WGM = 8;

__host__ __device__ __forceinline__ int lds_byte(int r, int c) { const int st = (r >> 4) * 2 + (c >> 5), rr = r & 15, cc = c & 31, ob = rr * 64 + cc * 2; return st * 1024 + (ob ^ (((ob >> 9) & 1) << 5)); }
__host__ __device__ __forceinline__ void stage_rc(int b, int& R, int& C) { const int st = b / 1024, sb = b % 1024, swz = sb ^ (((sb >> 9) & 1) << 5); R = (st >> 1) * 16 + swz / 64; C = (st & 1) * 32 + (swz % 64) / 2; }
__host__ __device__ __forceinline__ int perm32(int rho) { const int n = rho >> 4, i = rho & 15; return 8 * (i >> 2) + 4 * n + (i & 3); }

struct Unit { int pm, pn; };
struct Gemm { const bf16_t* A; const bf16_t* Bt; int M, N, K; };

struct StaticOrder {
    int nM, nN, nwg, G, c;
    __host__ __device__ void init(int M, int N, int G_, int c_) { nM = M / BM; nN = N / BM; nwg = nM * nN; G = G_; c = c_; }
    __host__ __device__ bool next(int i, Unit& u) const {
        const long L = (long)i * G + c; if (L >= nwg) return false;
        int wgid = (int)L; { const int q = nwg / NXCD, r = nwg % NXCD, xcd = wgid % NXCD, off = wgid / NXCD; wgid = (xcd < r ? xcd * (q + 1) : r * (q + 1) + (xcd - r) * q) + off; }
        const int nig = WGM * nN, gid = wgid / nig, fm = gid * WGM, gsz = (nM - fm) < WGM ? (nM - fm) : WGM;
        u.pm = fm + ((wgid % nig) % gsz); u.pn = (wgid % nig) / gsz; return true;
    }
    __device__ __forceinline__ void a_ready(const Unit&) const {}
    __device__ __forceinline__ void done(const Unit&) const {}
};

__device__ __forceinline__ unsigned cvt_pk_bf16(float lo, float hi) { unsigned r; asm volatile("v_cvt_pk_bf16_f32 %0, %1, %2" : "=v"(r) : "v"(lo), "v"(hi)); return r; }
typedef float f32x2 __attribute__((ext_vector_type(2)));
__device__ __forceinline__ f32x2 gelu_pk(f32x2 v) {
    const f32x2 av = __builtin_elementwise_abs(v), d = av * 0.2316418882f + 1.0f;
    f32x2 t; t.x = __builtin_amdgcn_rcpf(d.x); t.y = __builtin_amdgcn_rcpf(d.y);
    f32x2 q = t * 0.5307027145f + (-0.7265760135f); q = q * t + 0.7107068705f; q = q * t + (-0.142248368f); q = q * t + 0.127414796f; q = q * t;
    const f32x2 s = (v * v) * (-0.72134752044f);
    f32x2 e; e.x = __builtin_amdgcn_exp2f(s.x); e.y = __builtin_amdgcn_exp2f(s.y);
    const f32x2 m = v * (q * e), r = v - m;
    f32x2 o; o.x = v.x < 0.f ? m.x : r.x; o.y = v.y < 0.f ? m.y : r.y; return o;
}

template <int ACT  > struct EpiBf16 {
    static constexpr bool PERM = true, AFTER_DRAIN = false; static_assert(ACT == 0 || ACT == 1, "EpiBf16: ACT is 0 (none) or 1 (gelu_pk)");
    bf16_t* O; int ldc; const float* bias; int split_cols; size_t split_stride; float scale0;
    __device__ __forceinline__ void operator()(const f32x4 (&acc)[2][2][4][2], const Unit& u, int wr, int wc, int fr, int fq) const {
        const int row0 = u.pm * BM + wr * 64 + fr; int colt = u.pn * BM; bf16_t* base = O;
        float sc = 1.f; if (split_cols) { const int t = colt / split_cols; base += (size_t)t * split_stride; colt -= t * split_cols; if (t == 0) sc = scale0; }
        const int col0 = colt + wc * 32 + 8 * fq, bcol0 = u.pn * BM + wc * 32 + 8 * fq;
        f32x4 bv[2][2];
#pragma unroll
        for (int bj = 0; bj < 2; ++bj)
#pragma unroll
            for (int n = 0; n < 2; ++n) bv[bj][n] = bias ? *(const f32x4*)(bias + bcol0 + bj * HALF + 4 * n) : (f32x4){0.f, 0.f, 0.f, 0.f};
#pragma unroll
        for (int ai = 0; ai < 2; ++ai)
#pragma unroll
            for (int m = 0; m < 4; ++m) { bf16_t* rowp = base + (size_t)(row0 + ai * HALF + m * 16) * ldc + col0;
#pragma unroll
                for (int bj = 0; bj < 2; ++bj) { f32x4 v0 = acc[ai][bj][m][0] + bv[bj][0], v1 = acc[ai][bj][m][1] + bv[bj][1];
                    if (ACT == 1) { f32x2 a = gelu_pk((f32x2){v0[0], v0[1]}), b = gelu_pk((f32x2){v0[2], v0[3]}), c = gelu_pk((f32x2){v1[0], v1[1]}), d = gelu_pk((f32x2){v1[2], v1[3]});
                        v0 = (f32x4){a.x, a.y, b.x, b.y}; v1 = (f32x4){c.x, c.y, d.x, d.y}; }
                    v0 = v0 * sc; v1 = v1 * sc; u32x4 w; w.x = cvt_pk_bf16(v0[0], v0[1]); w.y = cvt_pk_bf16(v0[2], v0[3]); w.z = cvt_pk_bf16(v1[0], v1[1]); w.w = cvt_pk_bf16(v1[2], v1[3]);
                    *(u32x4*)(rowp + bj * HALF) = w; } }
    }
};

template <class Epi, class Sched, bool ALIGN_EPI = false, bool SP2 = false, bool SWAP = false>
__device__ __forceinline__ void gemm_phase(PG8_LAS unsigned char* lds, const Gemm g, const Sched& S, const Epi& E) {
    const int tid = threadIdx.x, wid = __builtin_amdgcn_readfirstlane(tid >> 6), lane = tid & 63, wr = wid >> 2, wc = wid & 3, fr = lane & 15, fq = lane >> 4;
    const int K = g.K, nt = K / BK;
    unsigned voffA[2], voffB[2];
#pragma unroll
    for (int i = 0; i < 2; ++i) { int R, C; stage_rc(tid * 16 + i * 8192, R, C); const int Rb = Epi::PERM ? ((R & ~31) + perm32(R & 31)) : R;
        voffA[i] = (unsigned)(R * K + C) * 2u; voffB[i] = (unsigned)(Rb * K + C) * 2u; }
    const size_t kstep = (size_t)(BK * 2);
    const size_t hstep = (size_t)HALF * K * 2;
    const size_t tstep = 2 * hstep;
    const unsigned ldsw = (unsigned)wid * 1024u;
    const int aoff = lds_byte(wr * 64 + fr, fq * 8), boff = lds_byte(wc * 32 + fr, fq * 8);
#define PG8_SA(b, h) (((b) * 2 + (h)) * HTB)
#define PG8_SB(b, h) ((4 + (b) * 2 + (h)) * HTB)
#define PG8_STAGE(bufoff, gbase, voff) do { _Pragma("unroll") for (int _i = 0; _i < 2; ++_i) \
        __builtin_amdgcn_global_load_lds((const unsigned*)((const char*)(gbase) + (voff)[_i]), (PG8_LAS unsigned*)(lds + (bufoff) + ldsw + _i * 8192), 16, 0, 0); } while (0)
#define PG8_LDA(dst, b, h) do { _Pragma("unroll") for (int m = 0; m < 4; ++m) _Pragma("unroll") for (int k = 0; k < 2; ++k) dst[m][k] = *(const PG8_LAS bf16x8*)(lds + PG8_SA(b, h) + aoff + m * 2048 + k * 1024); } while (0)
#define PG8_LDB(dst, b, h) do { _Pragma("unroll") for (int n = 0; n < 2; ++n) _Pragma("unroll") for (int k = 0; k < 2; ++k) dst[n][k] = *(const PG8_LAS bf16x8*)(lds + PG8_SB(b, h) + boff + n * 2048 + k * 1024); } while (0)
#define PG8_MMA(ai, bj, At, Bt) do { __builtin_amdgcn_s_setprio(1); _Pragma("unroll") for (int m = 0; m < 4; ++m) _Pragma("unroll") for (int n = 0; n < 2; ++n) _Pragma("unroll") for (int k = 0; k < 2; ++k) \
        acc[ai][bj][m][n] = SWAP ? __builtin_amdgcn_mfma_f32_16x16x32_bf16(At[m][k], Bt[n][k], acc[ai][bj][m][n], 0, 0, 0) : __builtin_amdgcn_mfma_f32_16x16x32_bf16(Bt[n][k], At[m][k], acc[ai][bj][m][n], 0, 0, 0); __builtin_amdgcn_s_setprio(0); } while (0)
#define PG8_WAIT_V(n) asm volatile("s_waitcnt vmcnt(" #n ")" ::: "memory")
#define PG8_WAIT_L(n) asm volatile("s_waitcnt lgkmcnt(" #n ")" ::: "memory")
#define PG8_BAR __builtin_amdgcn_s_barrier()
#define PG8_SCHED __builtin_amdgcn_sched_barrier(0)
    Unit cur, nxt; int ui = 0;
    if (!S.next(0, cur)) return;
    f32x4 acc[2][2][4][2];
#pragma unroll
    for (int a = 0; a < 2; ++a)
#pragma unroll
        for (int b = 0; b < 2; ++b)
#pragma unroll
            for (int m = 0; m < 4; ++m)
#pragma unroll
                for (int n = 0; n < 2; ++n) acc[a][b][m][n] = (f32x4){0.f, 0.f, 0.f, 0.f};
    bf16x8 At[4][2], B0[2][2], B1[2][2];
    const char* cA = (const char*)g.A + (size_t)cur.pm * tstep; const char* cB = (const char*)g.Bt + (size_t)cur.pn * tstep;
    S.a_ready(cur);
    if constexpr (SP2) {
        PG8_STAGE(PG8_SB(0, 0), cB, voffB); PG8_STAGE(PG8_SB(0, 1), cB + hstep, voffB); PG8_STAGE(PG8_SA(0, 0), cA, voffA); PG8_STAGE(PG8_SA(0, 1), cA + hstep, voffA);
        if (wr == 1) PG8_BAR;
        PG8_WAIT_V(2); PG8_BAR;
        PG8_STAGE(PG8_SB(1, 0), cB + kstep, voffB); PG8_STAGE(PG8_SA(1, 0), cA + kstep, voffA); PG8_STAGE(PG8_SB(1, 1), cB + hstep + kstep, voffB);
        PG8_WAIT_V(6); PG8_BAR;
    } else {
        PG8_STAGE(PG8_SB(0, 0), cB, voffB); PG8_STAGE(PG8_SA(0, 0), cA, voffA); PG8_STAGE(PG8_SB(0, 1), cB + hstep, voffB); PG8_STAGE(PG8_SA(0, 1), cA + hstep, voffA);
        if (wr == 1) PG8_BAR;
        PG8_WAIT_V(4); PG8_BAR;
        PG8_STAGE(PG8_SB(1, 0), cB + kstep, voffB); PG8_STAGE(PG8_SA(1, 0), cA + kstep, voffA); PG8_STAGE(PG8_SB(1, 1), cB + hstep + kstep, voffB);
        PG8_WAIT_V(6); PG8_BAR;
    }
    for (;;) {
        const bool has_next = S.next(ui + 1, nxt);
        const char* nA = has_next ? (const char*)g.A + (size_t)nxt.pm * tstep : cA; const char* nB = has_next ? (const char*)g.Bt + (size_t)nxt.pn * tstep : cB;
        for (int t = 0; t < nt; t += 2) {
            const bool last = (t == nt - 2);
            const char* a1 = cA + (size_t)(t + 1) * kstep;
            const char* a2 = last ? nA : cA + (size_t)(t + 2) * kstep; const char* b2 = last ? nB : cB + (size_t)(t + 2) * kstep;
            const char* a3 = a2 + kstep; const char* b3 = b2 + kstep;
            if (last && has_next) S.a_ready(nxt);
            if constexpr (SP2) {
            PG8_LDB(B0, 0, 0); PG8_LDB(B1, 0, 1); PG8_SCHED; PG8_LDA(At, 0, 0); PG8_STAGE(PG8_SA(1, 1), a1 + hstep, voffA);
            PG8_WAIT_V(8); PG8_WAIT_L(0); PG8_BAR; PG8_MMA(0, 0, At, B0); PG8_MMA(0, 1, At, B1); PG8_BAR; PG8_SCHED;
            PG8_LDA(At, 0, 1); PG8_STAGE(PG8_SB(0, 0), b2, voffB); PG8_STAGE(PG8_SB(0, 1), b2 + hstep, voffB); PG8_STAGE(PG8_SA(0, 0), a2, voffA);
            PG8_WAIT_V(8); PG8_WAIT_L(0); PG8_BAR; PG8_MMA(1, 0, At, B0); PG8_MMA(1, 1, At, B1); PG8_BAR; PG8_SCHED;
            PG8_LDB(B0, 1, 0); PG8_LDB(B1, 1, 1); PG8_SCHED; PG8_LDA(At, 1, 0); PG8_STAGE(PG8_SA(0, 1), a2 + hstep, voffA);
            PG8_WAIT_V(8); PG8_WAIT_L(0); PG8_BAR; PG8_MMA(0, 0, At, B0); PG8_MMA(0, 1, At, B1); PG8_BAR; PG8_SCHED;
            PG8_LDA(At, 1, 1); PG8_STAGE(PG8_SB(1, 0), b3, voffB); PG8_STAGE(PG8_SB(1, 1), b3 + hstep, voffB); PG8_STAGE(PG8_SA(1, 0), a3, voffA);
            PG8_WAIT_V(8); PG8_WAIT_L(0); PG8_BAR; PG8_MMA(1, 0, At, B0); PG8_MMA(1, 1, At, B1); PG8_BAR; PG8_SCHED;
            } else {
            PG8_LDB(B0, 0, 0); PG8_SCHED; PG8_LDA(At, 0, 0); PG8_STAGE(PG8_SA(1, 1), a1 + hstep, voffA);
            PG8_WAIT_L(8); PG8_BAR; PG8_WAIT_L(0); PG8_MMA(0, 0, At, B0); PG8_BAR; PG8_SCHED;
            PG8_LDB(B1, 0, 1); PG8_STAGE(PG8_SB(0, 0), b2, voffB);
            PG8_BAR; PG8_WAIT_L(0); PG8_MMA(0, 1, At, B1); PG8_BAR;
            PG8_LDA(At, 0, 1); PG8_STAGE(PG8_SA(0, 0), a2, voffA);
            PG8_BAR; PG8_WAIT_L(0); PG8_MMA(1, 0, At, B0); PG8_BAR; PG8_SCHED;
            PG8_STAGE(PG8_SB(0, 1), b2 + hstep, voffB);
            PG8_WAIT_V(6); PG8_BAR; PG8_MMA(1, 1, At, B1); PG8_BAR;
            PG8_LDB(B0, 1, 0); PG8_SCHED; PG8_LDA(At, 1, 0); PG8_STAGE(PG8_SA(0, 1), a2 + hstep, voffA);
            PG8_WAIT_L(8); PG8_BAR; PG8_WAIT_L(0); PG8_MMA(0, 0, At, B0); PG8_BAR; PG8_SCHED;
            PG8_LDB(B1, 1, 1); PG8_STAGE(PG8_SB(1, 0), b3, voffB);
            PG8_BAR; PG8_WAIT_L(0); PG8_MMA(0, 1, At, B1); PG8_BAR;
            PG8_LDA(At, 1, 1); PG8_STAGE(PG8_SA(1, 0), a3, voffA);
            PG8_BAR; PG8_WAIT_L(0); PG8_MMA(1, 0, At, B0); PG8_BAR; PG8_SCHED;
            PG8_STAGE(PG8_SB(1, 1), b3 + hstep, voffB);
            PG8_WAIT_V(6); PG8_BAR; PG8_MMA(1, 1, At, B1); PG8_BAR;
            }
        }
        if constexpr (ALIGN_EPI) { if (wr == 0) PG8_BAR; }
        if constexpr (!Epi::AFTER_DRAIN) { E(acc, cur, wr, wc, fr, fq); S.done(cur); }
        if (!has_next) break;
#pragma unroll
        for (int a = 0; a < 2; ++a)
#pragma unroll
            for (int b = 0; b < 2; ++b)
#pragma unroll
                for (int m = 0; m < 4; ++m)
#pragma unroll
                    for (int n = 0; n < 2; ++n) acc[a][b][m][n] = (f32x4){0.f, 0.f, 0.f, 0.f};
        cur = nxt; cA = nA; cB = nB; ++ui;
        if constexpr (ALIGN_EPI) { if (wr == 1) PG8_BAR; }
    }
    PG8_WAIT_V(0);
    if constexpr (!ALIGN_EPI) { if (wr == 0) PG8_BAR; }
    PG8_BAR;
    if constexpr (Epi::AFTER_DRAIN) { E.fused(acc, cur, wr, wc, fr, fq, lds, wid, lane); S.done(cur); }
#undef PG8_SA
#undef PG8_SB
#undef PG8_STAGE
#undef PG8_LDA
#undef PG8_LDB
#undef PG8_MMA
#undef PG8_WAIT_V
#undef PG8_WAIT_L
#undef PG8_BAR
#undef PG8_SCHED
}
}
#ifndef PG8_SP2
#define PG8_SP2 true
#endif

constexpr int NWAVES = 8;
constexpr int BATCH = 2, SEQ = 8192, M = BATCH * SEQ, DM = 1024, DIN = 2840, NPROJ = 3072, CC = 512, NH = 8, HD = 64, NKV = 2, GQ = 4;
constexpr int NCMP = 511, NCP = 512, NSEL = 128, NTOP = 16, WIN = 512, DFF = 2816, CMPH = 256, CMPK = 2048;
constexpr int SC_CB = 0, SC_CC = 512, SC_CH = 1024, SC_Q = 1536, SC_KC = 2048, SC_VC = 2176, SC_KS = 2304, SC_VS = 2432, SC_KW = 2560, SC_VW = 2688, SC_G = 2816;
constexpr float EPS = 1e-6f;
constexpr float LOG2E = 1.4426950408889634f;
constexpr float C2 = 0.125f * LOG2E;

constexpr size_t MiB = 1u << 20;
constexpr size_t WS_CTL = 0, CTL_ZERO_BYTES = 1 * MiB;
constexpr size_t WS_SSQ1 = 1 * MiB, WS_SSQ2 = 2 * MiB;
constexpr size_t WS_GATE = 3 * MiB;
constexpr size_t WS_KCMP = 5 * MiB, WS_VCMPT = 5 * MiB + 512 * 1024;
constexpr size_t WS_WIN = 6 * MiB, WS_WOUT = 12 * MiB, WS_WGU = 14 * MiB, WS_WDN = 25 * MiB;
constexpr size_t WS_CW1K = 30 * MiB + 512 * 1024, WS_CW1V = 31 * MiB + 512 * 1024, WS_CW2K = 32 * MiB + 512 * 1024, WS_CW2V = WS_CW2K + 32 * 1024;
constexpr size_t WS_C1P = WS_CW2K + 64 * 1024;
constexpr size_t WS_XN = 34 * MiB;
constexpr size_t WS_CB = 66 * MiB, WS_U = 82 * MiB, WS_Q = 98 * MiB, WS_KCVC = 114 * MiB, WS_KSKW = 122 * MiB, WS_VST = 130 * MiB, WS_VWT = 134 * MiB;
constexpr size_t WS_MIXED = 138 * MiB;
constexpr size_t WS_ACT = 66 * MiB;
constexpr size_t WS_NSAOUT = 170 * MiB, WS_ACMP = 202 * MiB, WS_HID = 220 * MiB, WS_COUT = 223 * MiB;
constexpr size_t WS_END = 256 * MiB;
constexpr int CW_TMO = 0, CW_CODE = 1, CW_BAR = 4096;

constexpr int RING_OFF = 0, RING_BYTES = 131072;
constexpr int LDSCTL_OFF = RING_BYTES, MISC_OFF = LDSCTL_OFF + 320;
constexpr int LDS_BYTES = 147456;

#define GAS __attribute__((address_space(1)))
#define LAS __attribute__((address_space(3)))
typedef unsigned short bf16;
typedef unsigned v4u __attribute__((ext_vector_type(4)));
typedef unsigned v2u __attribute__((ext_vector_type(2)));
typedef float f32x4 __attribute__((ext_vector_type(4)));
typedef short bf16x8 __attribute__((ext_vector_type(8)));
typedef GAS unsigned gu32;
#define RLX_AGENT __ATOMIC_RELAXED, __HIP_MEMORY_SCOPE_AGENT
#define LDS_WAIT() asm volatile("s_waitcnt lgkmcnt(0)" ::: "memory")
#define VM_WAIT() asm volatile("s_waitcnt vmcnt(0)" ::: "memory")
__device__ __forceinline__ unsigned f2bf(float f) { unsigned u = __builtin_bit_cast(unsigned, f); return (u + 0x7fffu + ((u >> 16) & 1u)) >> 16; }
__device__ __forceinline__ unsigned pk2(float lo, float hi) { return f2bf(lo) | (f2bf(hi) << 16); }
__device__ __forceinline__ float bf2f(unsigned b) { return __uint_as_float(b << 16); }
__device__ __forceinline__ float bflo(unsigned w) { return __uint_as_float(w << 16); }
__device__ __forceinline__ float bfhi(unsigned w) { return __uint_as_float(w & 0xffff0000u); }

#define XB_TMO      128
#define XB_XCNT(j)  (256  + 64 * (j))
#define XB_XSUB(j)  (1280 + 64 * (j))
#define XB_XGEN(j)  (2304 + 64 * (j))
#define XB_TOP      3328
#define XB_TOPGEN   3392
#define XCD_BAR_WORDS 3456
#define XB_SPIN_CAP (1u << 18)
__device__ __forceinline__ unsigned xb_ld(unsigned* p)              { return __hip_atomic_load(p, __ATOMIC_RELAXED, __HIP_MEMORY_SCOPE_AGENT); }
__device__ __forceinline__ unsigned xb_add(unsigned* p, unsigned v) { return __hip_atomic_fetch_add(p, v, __ATOMIC_RELAXED, __HIP_MEMORY_SCOPE_AGENT); }
__device__ __forceinline__ unsigned xb_xcc_id() { return (unsigned)__builtin_amdgcn_s_getreg((3 << 11) | 20) & 0xFu; }
#define XB_SPIN(cond, bar) do { unsigned _sp = 0; while (cond) { __builtin_amdgcn_s_sleep(1); \
    if ((++_sp & 255u) == 0u) { if (xb_ld(&(bar)[XB_TMO])) break; if (_sp > XB_SPIN_CAP) { atomicAdd(&(bar)[XB_TMO], 1u); break; } } } } while (0)
struct XcdBarrier { unsigned* bar; unsigned x; volatile LAS unsigned* st; };
__device__ __forceinline__ XcdBarrier xcd_barrier_post(unsigned* bar, volatile LAS unsigned* st) {
    XcdBarrier b; b.bar = bar; b.x = xb_xcc_id(); b.st = st;
    if (threadIdx.x == 0) (void)xb_add(&bar[XB_XCNT(b.x)], 1u);
    return b;
}
__device__ __forceinline__ void xcd_barrier_complete(unsigned* bar, unsigned x, unsigned& nloc, unsigned& nx) {
    const unsigned G = gridDim.x * gridDim.y * gridDim.z;
    unsigned sum, cnt, mine, sp = 0u;
    for (;;) {
        sum = 0u; cnt = 0u; mine = 0u;
#pragma unroll
        for (unsigned j = 0; j < 16; ++j) { const unsigned c = xb_ld(&bar[XB_XCNT(j)]); sum += c; cnt += (c > 0u) ? 1u : 0u; mine = (j == x) ? c : mine; }
        if (sum == G) break;
        __builtin_amdgcn_s_sleep(1);
        if ((++sp & 255u) == 0u) { if (xb_ld(&bar[XB_TMO])) break; if (sp > XB_SPIN_CAP) { atomicAdd(&bar[XB_TMO], 1u); break; } }
    }
    nloc = mine > 0u ? mine : 1u; nx = cnt > 0u ? cnt : 1u;
}
__device__ __forceinline__ void xcd_barrier(const XcdBarrier& b) {
    asm volatile("s_waitcnt vmcnt(0)" ::: "memory");
    __syncthreads();
    if (threadIdx.x == 0) {
        unsigned* bar = b.bar;
        __builtin_amdgcn_s_waitcnt(0);
        unsigned nloc = b.st[0], nx = b.st[1];
        if (nloc == 0u) { xcd_barrier_complete(bar, b.x, nloc, nx); b.st[0] = nloc; b.st[1] = nx; }
        const unsigned old = xb_add(&bar[XB_XSUB(b.x)], 1u);
        const unsigned gen = old / nloc;
        if (old + 1u == (gen + 1u) * nloc) {
            __builtin_amdgcn_fence(__ATOMIC_RELEASE, "agent");
            asm volatile("s_waitcnt vmcnt(0)" ::: "memory");
            const unsigned og = xb_add(&bar[XB_TOP], 1u);
            const unsigned tg = og / nx;
            if (og + 1u == (tg + 1u) * nx) xb_add(&bar[XB_TOPGEN], 1u);
            else XB_SPIN(xb_ld(&bar[XB_TOPGEN]) == tg, bar);
            __builtin_amdgcn_fence(__ATOMIC_ACQUIRE, "agent");
            xb_add(&bar[XB_XGEN(b.x)], 1u);
            asm volatile("s_waitcnt vmcnt(0)" ::: "memory");
        } else {
            XB_SPIN(xb_ld(&bar[XB_XGEN(b.x)]) == gen, bar);
            __builtin_amdgcn_fence(__ATOMIC_ACQUIRE, "agent");
            asm volatile("s_waitcnt vmcnt(0)" ::: "memory");
        }
    }
    __syncthreads();
}

struct Frame {
    LAS unsigned char* lds;
    volatile LAS unsigned* MISC;
    gu32* ctl;
    int tid, lane, wave;
    int vcu, G;
    const float* in[18];
    float* out; unsigned char* ws;
};
__device__ __forceinline__ float wave_sum(float v) {
#pragma unroll
    for (int o = 1; o < 64; o <<= 1) v += __shfl_xor(v, o);
    return v;
}

namespace pg8 {
struct EpiInProj {
    static constexpr bool PERM = true, AFTER_DRAIN = false;
    bf16_t *CB, *U, *Q, *KCVC, *KSKW; float* GATE;
    __device__ __forceinline__ void operator()(const f32x4 (&acc)[2][2][4][2], const Unit& u, int wr, int wc, int fr, int fq) const {
        const int row0 = u.pm * BM + wr * 64 + fr; const int pn = u.pn;
        if (pn >= 2 && pn <= 5) {
#pragma unroll
            for (int ai = 0; ai < 2; ++ai)
#pragma unroll
                for (int m = 0; m < 4; ++m) { bf16_t* rowp = U + (size_t)(row0 + ai * HALF + m * 16) * 512 + (pn - 2) * 128 + wc * 32 + 8 * fq;
                    const f32x4 v0 = acc[ai][0][m][0] * acc[ai][1][m][0], v1 = acc[ai][0][m][1] * acc[ai][1][m][1];
                    u32x4 w; w.x = cvt_pk_bf16(v0[0], v0[1]); w.y = cvt_pk_bf16(v0[2], v0[3]); w.z = cvt_pk_bf16(v1[0], v1[1]); w.w = cvt_pk_bf16(v1[2], v1[3]);
                    *(u32x4*)rowp = w; }
        } else if (pn == 11) {
            if (wc == 0 && fq < 3) {
#pragma unroll
                for (int ai = 0; ai < 2; ++ai)
#pragma unroll
                    for (int m = 0; m < 4; ++m) { float* gp = GATE + (size_t)(row0 + ai * HALF + m * 16) * 32 + 8 * fq;
#pragma unroll
                        for (int n = 0; n < 2; ++n) { const f32x4 v = acc[ai][0][m][n]; f32x4 o;
#pragma unroll
                            for (int i = 0; i < 4; ++i) o[i] = __builtin_amdgcn_rcpf(1.0f + __builtin_amdgcn_exp2f(-v[i] * 1.4426950408889634f));
                            *(f32x4*)(gp + 4 * n) = o; } }
            }
        } else {
            bf16_t* base; int ld, coff; float sc = 1.f;
            if (pn < 2) { base = CB; ld = 512; coff = pn * 256; }
            else if (pn < 8) { base = Q; ld = 512; coff = (pn - 6) * 256; sc = 0.125f * 1.4426950408889634f; }
            else if (pn == 8) { base = KCVC; ld = 256; coff = 0; }
            else { base = KSKW; ld = 256; coff = 0; }
#pragma unroll
            for (int ai = 0; ai < 2; ++ai)
#pragma unroll
                for (int m = 0; m < 4; ++m) { bf16_t* rowp = base + (size_t)(row0 + ai * HALF + m * 16) * ld + coff + wc * 32 + 8 * fq;
#pragma unroll
                    for (int bj = 0; bj < 2; ++bj) { const f32x4 v0 = acc[ai][bj][m][0] * sc, v1 = acc[ai][bj][m][1] * sc;
                        u32x4 w; w.x = cvt_pk_bf16(v0[0], v0[1]); w.y = cvt_pk_bf16(v0[2], v0[3]); w.z = cvt_pk_bf16(v1[0], v1[1]); w.w = cvt_pk_bf16(v1[2], v1[3]);
                        *(u32x4*)(rowp + bj * HALF) = w; } }
        }
    }
};
struct EpiVT {
    static constexpr bool PERM = false, AFTER_DRAIN = false;
    bf16_t *VST, *VWT;
    __device__ __forceinline__ void operator()(const f32x4 (&acc)[2][2][4][2], const Unit& u, int wr, int wc, int fr, int fq) const {
#pragma unroll
        for (int ai = 0; ai < 2; ++ai) {
            const int tok0 = u.pm * BM + ai * HALF + wr * 64; const int b = tok0 / 8192, blk = (tok0 % 8192) / 64;
#pragma unroll
            for (int bj = 0; bj < 2; ++bj)
#pragma unroll
                for (int n = 0; n < 2; ++n) { const int col = wc * 32 + n * 16 + fr, g = col >> 6, d = col & 63;
                    bf16_t* dp = (bj ? VWT : VST) + ((size_t)(((b * 2 + g) * 128 + blk) * 64 + d)) * 64 + 8 * (fq & 1) + 4 * (fq >> 1);
#pragma unroll
                    for (int m = 0; m < 4; ++m) { const f32x4 v = acc[ai][bj][m][n]; typedef unsigned u32x2 __attribute__((ext_vector_type(2)));
                        u32x2 w; w.x = cvt_pk_bf16(v[0], v[1]); w.y = cvt_pk_bf16(v[2], v[3]); *(u32x2*)(dp + 16 * m) = w; } }
        }
    }
};
struct EpiOutProj {
    static constexpr bool PERM = false, AFTER_DRAIN = false;
    const float* X; float* H; bf16_t* HBF; float* SSQ;
    __device__ __forceinline__ void operator()(const f32x4 (&acc)[2][2][4][2], const Unit& u, int wr, int wc, int fr, int fq) const {
        const int col0 = u.pn * BM + wc * 32 + 4 * fq;
#pragma unroll
        for (int ai = 0; ai < 2; ++ai)
#pragma unroll
            for (int m = 0; m < 4; ++m) { const int row = u.pm * BM + ai * HALF + wr * 64 + m * 16 + fr; const size_t off = (size_t)row * 1024 + col0; float s = 0.f;
#pragma unroll
                for (int bj = 0; bj < 2; ++bj)
#pragma unroll
                    for (int n = 0; n < 2; ++n) { const f32x4 h = *(const f32x4*)(X + off + bj * HALF + n * 16) + acc[ai][bj][m][n];
                        *(f32x4*)(H + off + bj * HALF + n * 16) = h; typedef unsigned u32x2 __attribute__((ext_vector_type(2)));
                        u32x2 w; w.x = cvt_pk_bf16(h[0], h[1]); w.y = cvt_pk_bf16(h[2], h[3]); *(u32x2*)(HBF + off + bj * HALF + n * 16) = w;
                        s += (h[0] * h[0] + h[1] * h[1]) + (h[2] * h[2] + h[3] * h[3]); }
                s += __shfl_xor(s, 16); s += __shfl_xor(s, 32);
                if (fq == 0) SSQ[(size_t)row * 16 + u.pn * 4 + wc] = s;
                asm volatile("" ::: "memory"); }
    }
};
struct EpiDown {
    static constexpr bool PERM = false, AFTER_DRAIN = false;
    float* H; float* SSQ;
    __device__ __forceinline__ void operator()(const f32x4 (&acc)[2][2][4][2], const Unit& u, int wr, int wc, int fr, int fq) const {
        const int col0 = u.pn * BM + wc * 32 + 4 * fq;
#pragma unroll
        for (int ai = 0; ai < 2; ++ai)
#pragma unroll
            for (int m = 0; m < 4; ++m) { const int row = u.pm * BM + ai * HALF + wr * 64 + m * 16 + fr; const size_t off = (size_t)row * 1024 + col0; float s = 0.f;
#pragma unroll
                for (int bj = 0; bj < 2; ++bj)
#pragma unroll
                    for (int n = 0; n < 2; ++n) { const f32x4 h = *(const f32x4*)(H + off + bj * HALF + n * 16) + acc[ai][bj][m][n];
                        *(f32x4*)(H + off + bj * HALF + n * 16) = h;
                        s += (h[0] * h[0] + h[1] * h[1]) + (h[2] * h[2] + h[3] * h[3]); }
                s += __shfl_xor(s, 16); s += __shfl_xor(s, 32);
                if (fq == 0) SSQ[(size_t)row * 16 + u.pn * 4 + wc] = s;
                asm volatile("" ::: "memory"); }
    }
};
struct EpiSwiGLU {
    static constexpr bool PERM = true, AFTER_DRAIN = false;
    const float* SSQ; bf16_t* ACT;
    __device__ __forceinline__ void operator()(const f32x4 (&acc)[2][2][4][2], const Unit& u, int wr, int wc, int fr, int fq) const {
        const int row0 = u.pm * BM + wr * 64 + fr;
#pragma unroll
        for (int ai = 0; ai < 2; ++ai)
#pragma unroll
            for (int m = 0; m < 4; ++m) { const int row = row0 + ai * HALF + m * 16; const f32x4* sp = (const f32x4*)(SSQ + (size_t)row * 16);
                const f32x4 a = sp[0], b = sp[1], c = sp[2], d = sp[3];
                const float ss = ((a[0] + a[1]) + (a[2] + a[3])) + ((b[0] + b[1]) + (b[2] + b[3])) + ((c[0] + c[1]) + (c[2] + c[3])) + ((d[0] + d[1]) + (d[2] + d[3]));
                const float rs = 1.0f / sqrtf(ss * (1.0f / 1024.0f) + 1e-6f);
                float o[8];
#pragma unroll
                for (int n = 0; n < 2; ++n)
#pragma unroll
                    for (int i = 0; i < 4; ++i) { const float g = acc[ai][0][m][n][i] * rs, up = acc[ai][1][m][n][i] * rs;
                        o[4 * n + i] = g * __builtin_amdgcn_rcpf(1.0f + __builtin_amdgcn_exp2f(-g * 1.4426950408889634f)) * up; }
                u32x4 w; w.x = cvt_pk_bf16(o[0], o[1]); w.y = cvt_pk_bf16(o[2], o[3]); w.z = cvt_pk_bf16(o[4], o[5]); w.w = cvt_pk_bf16(o[6], o[7]);
                *(u32x4*)(ACT + (size_t)row * 2816 + u.pn * 128 + wc * 32 + 8 * fq) = w;
                asm volatile("" ::: "memory"); }
    }
};
struct OrderInA { StaticOrder S;
    __device__ bool next(int i, Unit& u) const { const bool ok = S.next(i, u); if (ok && u.pn == 10) u.pn = 11; return ok; }
    __device__ __forceinline__ void a_ready(const Unit&) const {}
    __device__ __forceinline__ void done(const Unit&) const {} };
struct OrderInB { int G, c;
    __device__ bool next(int i, Unit& u) const { const int L = i * G + (c + G - (192 % G)) % G; if (L >= 64) return false; u.pm = L; u.pn = 10; return true; }
    __device__ __forceinline__ void a_ready(const Unit&) const {}
    __device__ __forceinline__ void done(const Unit&) const {} };
}

__device__ __forceinline__ void p0_item(const float* W, int N, int k0, int n0, int nvalid, const float* gk, bf16* WT, int ldw, int drow0, LAS float* scr, int lane) {
    const int n4 = (lane & 7) * 4, kq = lane >> 3;
    f32x4 v[8];
#pragma unroll
    for (int i = 0; i < 8; ++i) v[i] = (n4 < nvalid) ? *(const GAS f32x4*)(W + (size_t)(k0 + kq + 8 * i) * N + n0 + n4) : (f32x4){0.f, 0.f, 0.f, 0.f};
    if (gk) {
#pragma unroll
        for (int i = 0; i < 8; ++i) v[i] = v[i] * gk[k0 + kq + 8 * i];
    }
#pragma unroll
    for (int i = 0; i < 8; ++i)
#pragma unroll
        for (int e = 0; e < 4; ++e) scr[(n4 + e) * 68 + kq + 8 * i] = v[i][e];
    LDS_WAIT(); asm volatile("" ::: "memory");
    const int c = lane & 7;
#pragma unroll
    for (int j = 0; j < 4; ++j) { const int n = (lane >> 3) + 8 * j; const f32x4 a = *(const LAS f32x4*)(scr + n * 68 + 8 * c), bq = *(const LAS f32x4*)(scr + n * 68 + 8 * c + 4);
        v4u o; o.x = pk2(a[0], a[1]); o.y = pk2(a[2], a[3]); o.z = pk2(bq[0], bq[1]); o.w = pk2(bq[2], bq[3]);
        *(GAS v4u*)(WT + (size_t)(drow0 + n) * ldw + k0 + 8 * c) = o; }
    LDS_WAIT(); asm volatile("" ::: "memory");
}
__device__ __forceinline__ int win_dst_row(int n0) {
    if (n0 < SC_CC) return n0;
    if (n0 < SC_CH) { const int c = n0 - SC_CC; return 256 * (2 + (c >> 7)) + (c & 127); }
    if (n0 < SC_Q) { const int c = n0 - SC_CH; return 256 * (2 + (c >> 7)) + 128 + (c & 127); }
    if (n0 < SC_VS) return n0;
    if (n0 < SC_KW) return n0 + 128;
    if (n0 < SC_VW) return n0 - 128;
    return n0;
}
__device__ __forceinline__ void rms_row2_to_bf16(const float* x, const float* g, bf16* xn, int m0, int m1, int lane) {
    const GAS f32x4* x0 = (const GAS f32x4*)(x + (size_t)m0 * DM) + lane; const GAS f32x4* x1 = (const GAS f32x4*)(x + (size_t)m1 * DM) + lane; const GAS f32x4* gr = (const GAS f32x4*)g + lane;
    f32x4 v[4], w[4]; float s = 0.f, q = 0.f;
#pragma unroll
    for (int j = 0; j < 4; ++j) { v[j] = x0[64 * j]; w[j] = x1[64 * j]; }
#pragma unroll
    for (int j = 0; j < 4; ++j) { s += (v[j].x * v[j].x + v[j].y * v[j].y) + (v[j].z * v[j].z + v[j].w * v[j].w); q += (w[j].x * w[j].x + w[j].y * w[j].y) + (w[j].z * w[j].z + w[j].w * w[j].w); }
#pragma unroll
    for (int o = 1; o < 64; o <<= 1) { s += __shfl_xor(s, o); q += __shfl_xor(q, o); }
    const float r0 = 1.0f / sqrtf(s * (1.0f / 1024.0f) + EPS), r1 = 1.0f / sqrtf(q * (1.0f / 1024.0f) + EPS);
    GAS unsigned long long* o0 = (GAS unsigned long long*)(xn + (size_t)m0 * DM) + lane; GAS unsigned long long* o1 = (GAS unsigned long long*)(xn + (size_t)m1 * DM) + lane;
#pragma unroll
    for (int j = 0; j < 4; ++j) { const f32x4 gv = gr[64 * j];
        o0[64 * j] = (unsigned long long)pk2(v[j].x * r0 * gv.x, v[j].y * r0 * gv.y) | ((unsigned long long)pk2(v[j].z * r0 * gv.z, v[j].w * r0 * gv.w) << 32);
        o1[64 * j] = (unsigned long long)pk2(w[j].x * r1 * gv.x, w[j].y * r1 * gv.y) | ((unsigned long long)pk2(w[j].z * r1 * gv.z, w[j].w * r1 * gv.w) << 32); }
}
__device__ __forceinline__ void rms_row_to_bf16(const float* xrow, const float* g, bf16* orow, int lane) {
    const GAS f32x4* xr = (const GAS f32x4*)xrow + lane; const GAS f32x4* gr = (const GAS f32x4*)g + lane;
    f32x4 v[4]; float s = 0.f;
#pragma unroll
    for (int j = 0; j < 4; ++j) { v[j] = xr[64 * j]; s += (v[j].x * v[j].x + v[j].y * v[j].y) + (v[j].z * v[j].z + v[j].w * v[j].w); }
    const float r = 1.0f / sqrtf(wave_sum(s) * (1.0f / 1024.0f) + EPS);
    GAS unsigned long long* o8 = (GAS unsigned long long*)orow + lane;
#pragma unroll
    for (int j = 0; j < 4; ++j) { const f32x4 gv = gr[64 * j];
        o8[64 * j] = (unsigned long long)pk2(v[j].x * r * gv.x, v[j].y * r * gv.y) | ((unsigned long long)pk2(v[j].z * r * gv.z, v[j].w * r * gv.w) << 32); }
}
__device__ __forceinline__ void p0_prologue(Frame& F) {
    LAS float* scr = (LAS float*)(F.lds + RING_OFF + F.wave * 16384);
    const int gw = F.vcu * NWAVES + F.wave, NGW = F.G * NWAVES;
    bf16* WIN_T = (bf16*)(F.ws + WS_WIN);
    constexpr int I_IN = 16 * 89, I_C1 = 32 * 8, I_C2 = 4 * 2, I_Z = 448;
    constexpr int NITEMS = I_IN + 2 * I_C1 + 2 * I_C2 + I_Z;
    for (int it = gw; it < NITEMS; it += NGW) {
        int r = it;
        if (r < I_IN) { const int kb = r / 89, nb = r % 89, n0 = 32 * nb; p0_item(F.in[2], DIN, 64 * kb, n0, min(32, DIN - n0), nullptr, WIN_T, 1024, win_dst_row(n0), scr, F.lane); continue; } r -= I_IN;
        if (r < I_C1) { const int kb = r / 8, nb = r % 8; p0_item(F.in[5], CMPH, 64 * kb, 32 * nb, 32, nullptr, (bf16*)(F.ws + WS_CW1K), CMPK, 32 * nb, scr, F.lane); continue; } r -= I_C1;
        if (r < I_C1) { const int kb = r / 8, nb = r % 8; p0_item(F.in[8], CMPH, 64 * kb, 32 * nb, 32, nullptr, (bf16*)(F.ws + WS_CW1V), CMPK, 32 * nb, scr, F.lane); continue; } r -= I_C1;
        if (r < I_C2) { const int kb = r / 2, nb = r % 2; p0_item(F.in[6], HD, 64 * kb, 32 * nb, 32, nullptr, (bf16*)(F.ws + WS_CW2K), CMPH, 32 * nb, scr, F.lane); continue; } r -= I_C2;
        if (r < I_C2) { const int kb = r / 2, nb = r % 2; p0_item(F.in[9], HD, 64 * kb, 32 * nb, 32, nullptr, (bf16*)(F.ws + WS_CW2V), CMPH, 32 * nb, scr, F.lane); continue; } r -= I_C2;
        { GAS v4u* z = (GAS v4u*)(WIN_T + (size_t)2848 * 1024) + (size_t)r * 64 + F.lane; *z = (v4u){0u, 0u, 0u, 0u}; }
    }
    for (int m = gw; m < M; m += 2 * NGW) rms_row2_to_bf16(F.in[0], F.in[1], (bf16*)(F.ws + WS_XN), m, m + NGW, F.lane);
}
__device__ __forceinline__ void late_weights(Frame& F, int w, int nw) {
    LAS float* scr = (LAS float*)(F.lds + RING_OFF + F.wave * 16384);
    bf16* WOUT_T = (bf16*)(F.ws + WS_WOUT); bf16* WGU_T = (bf16*)(F.ws + WS_WGU); bf16* WDN_T = (bf16*)(F.ws + WS_WDN);
    constexpr int I_OUT = 16 * 32, I_G = 16 * 88, I_U = 16 * 88, I_DN = 44 * 32;
    constexpr int NITEMS = I_OUT + I_G + I_U + I_DN;
    for (int it = w; it < NITEMS; it += nw) {
        int r = it;
        if (r < I_OUT) { const int kb = r / 32, nb = r % 32; p0_item(F.in[12], 1024, 64 * kb, 32 * nb, 32, nullptr, WOUT_T, 1024, 32 * nb, scr, F.lane); continue; } r -= I_OUT;
        if (r < I_G) { const int kb = r / 88, nb = r % 88, n0 = 32 * nb; p0_item(F.in[14], DFF, 64 * kb, n0, 32, F.in[13], WGU_T, 1024, 256 * (n0 >> 7) + (n0 & 127), scr, F.lane); continue; } r -= I_G;
        if (r < I_U) { const int kb = r / 88, nb = r % 88, n0 = 32 * nb; p0_item(F.in[15], DFF, 64 * kb, n0, 32, F.in[13], WGU_T, 1024, 256 * (n0 >> 7) + 128 + (n0 & 127), scr, F.lane); continue; } r -= I_U;
        { const int kb = r / 32, nb = r % 32; p0_item(F.in[16], 1024, 64 * kb, 32 * nb, 32, nullptr, WDN_T, DFF, 32 * nb, scr, F.lane); }
    }
}

__device__ __forceinline__ void conv_token(const bf16* CB, const bf16* U, const float* cw, const float* gn, bf16* MIXED, int m, int lane) {
    const int t = m & (SEQ - 1);
    const v4u cb = *(const GAS v4u*)(CB + (size_t)m * 512 + 8 * lane);
    const v4u u2 = *(const GAS v4u*)(U + (size_t)m * 512 + 8 * lane);
    v4u u1 = (v4u){0u, 0u, 0u, 0u}, u0 = (v4u){0u, 0u, 0u, 0u};
    if (t >= 1) u1 = *(const GAS v4u*)(U + (size_t)(m - 1) * 512 + 8 * lane);
    if (t >= 2) u0 = *(const GAS v4u*)(U + (size_t)(m - 2) * 512 + 8 * lane);
    float y[8]; float s = 0.f;
#pragma unroll
    for (int i = 0; i < 4; ++i) {
        const int c = 8 * lane + 2 * i;
        const float a0 = cw[c] * bflo(u0[i]) + cw[512 + c] * bflo(u1[i]) + cw[1024 + c] * bflo(u2[i]);
        const float a1 = cw[c + 1] * bfhi(u0[i]) + cw[512 + c + 1] * bfhi(u1[i]) + cw[1024 + c + 1] * bfhi(u2[i]);
        y[2 * i] = bflo(cb[i]) * a0; y[2 * i + 1] = bfhi(cb[i]) * a1; s += y[2 * i] * y[2 * i] + y[2 * i + 1] * y[2 * i + 1];
    }
    const float r = 1.0f / sqrtf(wave_sum(s) * (1.0f / 512.0f) + EPS);
    v4u o;
#pragma unroll
    for (int i = 0; i < 4; ++i) { const int c = 8 * lane + 2 * i; o[i] = pk2(y[2 * i] * r * gn[c], y[2 * i + 1] * r * gn[c + 1]); }
    *(GAS v4u*)(MIXED + (size_t)m * 1024 + 8 * lane) = o;
}
__device__ __forceinline__ void final_row(const float* H, const float* SSQ, const float* g, float* out, int m, int lane) {
    const GAS f32x4* sp = (const GAS f32x4*)(SSQ + (size_t)m * 16);
    const f32x4 a = sp[0], b = sp[1], c = sp[2], d = sp[3];
    const float ss = ((a[0] + a[1]) + (a[2] + a[3])) + ((b[0] + b[1]) + (b[2] + b[3])) + ((c[0] + c[1]) + (c[2] + c[3])) + ((d[0] + d[1]) + (d[2] + d[3]));
    const float r = 1.0f / sqrtf(ss * (1.0f / 1024.0f) + EPS);
    const GAS f32x4* hr = (const GAS f32x4*)(H + (size_t)m * DM) + lane; const GAS f32x4* gr = (const GAS f32x4*)g + lane; GAS f32x4* o = (GAS f32x4*)(out + (size_t)m * DM) + lane;
    f32x4 v[4];
#pragma unroll
    for (int j = 0; j < 4; ++j) v[j] = hr[64 * j];
#pragma unroll
    for (int j = 0; j < 4; ++j) o[64 * j] = v[j] * r * gr[64 * j];
}

namespace slow {
__device__ __forceinline__ float wave_max(float v) {
#pragma unroll
    for (int o = 1; o < 64; o <<= 1) v = fmaxf(v, __shfl_xor(v, o));
    return v;
}
__device__ __forceinline__ int kslot(int k) { return 16 * (k >> 4) + 8 * ((k >> 2) & 1) + (k & 3) + 4 * ((k & 15) >> 3); }
template <int EPI>
__global__ void __launch_bounds__(256) gemm_f32(const float* A, int lda, const float* Bm, int ldb, float* C, int ldc, int Mr, int N, int K) {
    __shared__ float As[16][68];
    __shared__ float Bs[16][68];
    const int tid = threadIdx.x, tx = tid & 15, ty = tid >> 4;
    const int m0 = blockIdx.y * 64, n0 = blockIdx.x * 64;
    float acc[4][4];
#pragma unroll
    for (int i = 0; i < 4; ++i)
#pragma unroll
        for (int j = 0; j < 4; ++j) acc[i][j] = 0.f;
    const int ar = tid >> 2, ak = (tid & 3) * 4;
    const int bk = tid >> 4, bc = (tid & 15) * 4;
    for (int k0 = 0; k0 < K; k0 += 16) {
        float4 av = make_float4(0.f, 0.f, 0.f, 0.f), bv = make_float4(0.f, 0.f, 0.f, 0.f);
        if (m0 + ar < Mr) av = *(const float4*)(A + (size_t)(m0 + ar) * lda + k0 + ak);
        if (n0 + bc < N) bv = *(const float4*)(Bm + (size_t)(k0 + bk) * ldb + n0 + bc);
        __syncthreads();
        As[ak + 0][ar] = av.x; As[ak + 1][ar] = av.y; As[ak + 2][ar] = av.z; As[ak + 3][ar] = av.w;
        *(float4*)&Bs[bk][bc] = bv;
        __syncthreads();
#pragma unroll
        for (int k = 0; k < 16; ++k) {
            const float4 a = *(const float4*)&As[k][ty * 4];
            const float4 b = *(const float4*)&Bs[k][tx * 4];
            const float aa[4] = {a.x, a.y, a.z, a.w}, bb[4] = {b.x, b.y, b.z, b.w};
#pragma unroll
            for (int i = 0; i < 4; ++i)
#pragma unroll
                for (int j = 0; j < 4; ++j) acc[i][j] = fmaf(aa[i], bb[j], acc[i][j]);
        }
    }
#pragma unroll
    for (int i = 0; i < 4; ++i) {
        const int r = m0 + ty * 4 + i;
        if (r >= Mr) continue;
#pragma unroll
        for (int j = 0; j < 4; ++j) {
            const int c = n0 + tx * 4 + j;
            if (c >= N) continue;
            float v = acc[i][j];
            if (EPI == 1) v = 0.5f * v * (1.0f + tanhf(0.7978845608028654f * (v + 0.044715f * v * v * v)));
            C[(size_t)r * ldc + c] = v;
        }
    }
}
__global__ void cmp_gather_k(const bf16* KCVC, int coloff, const float* pos, float* A) {
    const size_t idx = (size_t)blockIdx.x * blockDim.x + threadIdx.x;
    if (idx >= (size_t)BATCH * NCMP * NKV * CMPK) return;
    const int kk = (int)(idx % CMPK); const int r = (int)(idx / CMPK);
    const int h = r % NKV, n = (r / NKV) % NCMP, b = r / (NKV * NCMP);
    const int l = kk / HD, d = kk % HD;
    A[idx] = bf2f(KCVC[(size_t)(b * SEQ + 16 * n + l) * 256 + coloff + h * HD + d]) + pos[l * HD + d];
}
__global__ void cmp_pack_k(const float* COUT, int isV, bf16* dst) {
    const int idx = blockIdx.x * blockDim.x + threadIdx.x;
    if (idx >= BATCH * NKV * NCP * HD) return;
    const int d = idx % HD, n = (idx / HD) % NCP, h = (idx / (HD * NCP)) % NKV, b = idx / (HD * NCP * NKV);
    const float v = (n < NCMP) ? COUT[(size_t)((b * NCMP + n) * NKV + h) * HD + d] : 0.f;
    if (!isV) dst[(size_t)((b * NKV + h) * NCP + n) * HD + d] = (bf16)f2bf(v);
    else dst[(size_t)((b * NKV + h) * HD + d) * NCP + (n & ~63) + kslot(n & 63)] = (bf16)f2bf(v);
}
__device__ __forceinline__ float block_reduce(float v, bool is_max, float* red) {
    const int tid = threadIdx.x;
    v = is_max ? wave_max(v) : wave_sum(v);
    __syncthreads();
    if ((tid & 63) == 0) red[tid >> 6] = v;
    __syncthreads();
    float r = red[0];
    for (int i = 1; i < 4; ++i) r = is_max ? fmaxf(r, red[i]) : r + red[i];
    return r;
}
__device__ void softmax4(float* sc, int ld, int n, float* red) {
    const int tid = threadIdx.x;
    for (int h = 0; h < 4; ++h) {
        float m = -INFINITY;
        for (int i = tid; i < n; i += 256) m = fmaxf(m, sc[h * ld + i]);
        m = block_reduce(m, true, red);
        if (!(m > -INFINITY)) m = 0.f;
        float s = 0.f;
        for (int i = tid; i < n; i += 256) { const float v = sc[h * ld + i]; const float e = (v > -INFINITY) ? exp2f(v - m) : 0.f; sc[h * ld + i] = e; s += e; }
        s = block_reduce(s, false, red);
        const float inv = 1.0f / fmaxf(s, 1e-30f);
        for (int i = tid; i < n; i += 256) sc[h * ld + i] *= inv;
        __syncthreads();
    }
}
__global__ void __launch_bounds__(256) nsa_k(const bf16* Q, const bf16* KCMP, const bf16* VCMPT, const bf16* KSKW, const bf16* VST, const bf16* VWT, const float* GATE, float* out) {
    __shared__ float q[4][64];
    __shared__ float sc[4][1024];
    __shared__ float imp[128];
    __shared__ int sel[16];
    __shared__ float red[4];
    __shared__ float oacc[4][64];
    const int tid = threadIdx.x;
    const int g = blockIdx.x % NKV, m = blockIdx.x / NKV, t = m % SEQ, b = m / SEQ;
    { const int h = tid >> 6, d = tid & 63; q[h][d] = bf2f(Q[(size_t)m * 512 + (g * GQ + h) * HD + d]); oacc[h][d] = 0.f; }
    __syncthreads();
    float slope[4];
#pragma unroll
    for (int h = 0; h < 4; ++h) slope[h] = exp2f(-(float)(g * GQ + h + 1)) * LOG2E;
    float gate[3];
    { const int h = tid >> 6;
#pragma unroll
      for (int br = 0; br < 3; ++br) gate[br] = GATE[(size_t)m * 32 + (g * GQ + h) * 3 + br]; }
    const bf16* kcb = KCMP + (size_t)(b * NKV + g) * NCP * HD; const bf16* vcb = VCMPT + (size_t)(b * NKV + g) * HD * NCP;
    for (int i = tid; i < 4 * 512; i += 256) {
        const int h = i >> 9, n = i & 511; float s = -INFINITY;
        if (n < NCMP && 16 * n + 31 <= t) {
            const bf16* kr = kcb + (size_t)n * HD; float a = 0.f;
            for (int d = 0; d < 64; ++d) a += q[h][d] * bf2f(kr[d]);
            s = a - slope[h] * (float)(t - (16 * n + 31));
        }
        sc[h][n] = s;
    }
    __syncthreads();
    softmax4(&sc[0][0], 1024, 512, red);
    { const int h = tid >> 6, d = tid & 63; float a = 0.f;
      for (int n = 0; n < NCMP; ++n) { if (16 * n + 31 > t) break; a += sc[h][n] * bf2f(vcb[(size_t)d * NCP + (n & ~63) + kslot(n & 63)]); }
      oacc[h][d] += gate[0] * a; }
    if (tid < 128) {
        const int j = tid; float a = 0.f;
        for (int h = 0; h < 4; ++h)
            for (int n = 4 * j - 1; n <= 4 * j + 3; ++n) {
                if (n < 0 || n >= NCMP) continue;
                const int lo = max(16 * n, 64 * j), hi = min(16 * n + 32, 64 * j + 64);
                a += sc[h][n] * ((float)max(hi - lo, 0) / 32.0f);
            }
        if (64 * j > t) a = -INFINITY;
        if (j == 0 || j == t / 64) a = INFINITY;
        imp[j] = a;
    }
    __syncthreads();
    if (tid < 128) {
        const int j = tid; const float v = imp[j]; int rank = 0;
        for (int i = 0; i < 128; ++i) { const float u = imp[i]; rank += (u > v || (u == v && i < j)) ? 1 : 0; }
        if (rank < NTOP) sel[rank] = j;
    }
    __syncthreads();
    for (int i = tid; i < 4 * 1024; i += 256) {
        const int h = i >> 10, mm = i & 1023; const int pos = sel[mm >> 6] * 64 + (mm & 63); float s = -INFINITY;
        if (pos <= t) {
            const bf16* kr = KSKW + (size_t)(b * SEQ + pos) * 256 + g * HD; float a = 0.f;
            for (int d = 0; d < 64; ++d) a += q[h][d] * bf2f(kr[d]);
            s = a - slope[h] * (float)(t - pos);
        }
        sc[h][mm] = s;
    }
    __syncthreads();
    softmax4(&sc[0][0], 1024, 1024, red);
    { const int h = tid >> 6, d = tid & 63; float a = 0.f;
      for (int mm = 0; mm < 1024; ++mm) { const int blk = sel[mm >> 6], k = mm & 63; if (blk * 64 + k > t) continue;
          a += sc[h][mm] * bf2f(VST[((size_t)((b * NKV + g) * 128 + blk) * 64 + d) * 64 + kslot(k)]); }
      oacc[h][d] += gate[1] * a; }
    __syncthreads();
    for (int i = tid; i < 4 * 512; i += 256) {
        const int h = i >> 9, mm = i & 511; const int pos = t - 511 + mm; float s = -INFINITY;
        if (pos >= 0) {
            const bf16* kr = KSKW + (size_t)(b * SEQ + pos) * 256 + 128 + g * HD; float a = 0.f;
            for (int d = 0; d < 64; ++d) a += q[h][d] * bf2f(kr[d]);
            s = a - slope[h] * (float)(t - pos);
        }
        sc[h][mm] = s;
    }
    __syncthreads();
    softmax4(&sc[0][0], 1024, 512, red);
    { const int h = tid >> 6, d = tid & 63; float a = 0.f;
      for (int mm = 0; mm < 512; ++mm) { const int pos = t - 511 + mm; if (pos < 0) continue;
          a += sc[h][mm] * bf2f(VWT[((size_t)((b * NKV + g) * 128 + (pos >> 6)) * 64 + d) * 64 + kslot(pos & 63)]); }
      oacc[h][d] += gate[2] * a;
      out[(size_t)m * 512 + (g * GQ + h) * HD + d] = oacc[h][d]; }
}
__global__ void rms_bf16_k(const float* in, const float* g, bf16* MIXED) {
    const int w = (blockIdx.x * blockDim.x + threadIdx.x) >> 6, lane = threadIdx.x & 63;
    if (w >= M) return;
    const float* x = in + (size_t)w * 512; float v[8]; float s = 0.f;
#pragma unroll
    for (int i = 0; i < 8; ++i) { v[i] = x[8 * lane + i]; s += v[i] * v[i]; }
    const float r = 1.0f / sqrtf(wave_sum(s) * (1.0f / 512.0f) + EPS);
    v4u o;
#pragma unroll
    for (int i = 0; i < 4; ++i) o[i] = pk2(v[2 * i] * r * g[8 * lane + 2 * i], v[2 * i + 1] * r * g[8 * lane + 2 * i + 1]);
    *(v4u*)(MIXED + (size_t)w * 1024 + 512 + 8 * lane) = o;
}
}

namespace cmp {
using f32x16 = __attribute__((ext_vector_type(16))) float;
typedef __bf16 bf16x2_t __attribute__((ext_vector_type(2)));
constexpr int L_X = 0, X_ROWS = 544, L_G = X_ROWS * 128, G_LD = 528  , L_POS = L_G + 32 * G_LD  , L_END = L_POS + 4096;
static_assert(L_END <= RING_BYTES, "cmp LDS map");
struct Ctx { const bf16* KCVC; const bf16 *W1K, *W1V, *W2K, *W2V; const float *POSK, *POSV; bf16* KCMP; bf16* VCMPT; };
__device__ __forceinline__ float gelu_tanh(float v) {
    const float u = 0.7978845608028654f * (v + 0.044715f * v * v * v);
    return v * __builtin_amdgcn_rcpf(1.0f + __builtin_amdgcn_exp2f(-2.0f * LOG2E * u));
}
__device__ __forceinline__ void cmp_unit(const Ctx& C, LAS unsigned char* lds, int u) {
    const int tid = threadIdx.x, lane = tid & 63, wave = __builtin_amdgcn_readfirstlane(tid >> 6), r32 = lane & 31, hi = lane >> 5;
    const int rt = u & 15, g = (u >> 4) & 1, b = (u >> 5) & 1, kv = u >> 6; const int n0 = 32 * rt;
    { const bf16* src = C.KCVC + ((size_t)b * SEQ + 16 * n0) * 256 + kv * 128 + g * 64;
      for (int q = tid; q < 528 * 8; q += 512) { const int tok = q >> 3, c8 = q & 7; const v4u v = *(const GAS v4u*)(src + (size_t)tok * 256 + c8 * 8);
          const int rho = (tok & 15) * 34 + (tok >> 4); *(LAS v4u*)(lds + L_X + rho * 128 + ((c8 ^ ((rho >> 1) & 7)) << 4)) = v; } }
    { const float* pos = kv ? C.POSV : C.POSK; for (int q = tid; q < 1024; q += 512) { const float2 pv = *(const float2*)(pos + 2 * q); *(LAS unsigned*)(lds + L_POS + 4 * q) = pk2(pv.x, pv.y); } }
    __syncthreads();
    f32x16 acc; float c1p = 0.f;
#pragma unroll
    for (int i = 0; i < 16; ++i) acc[i] = 0.f;
    const bf16* wrow = (kv ? C.W1V : C.W1K) + (size_t)(32 * wave + r32) * CMPK + 8 * hi;
#pragma unroll 1
    for (int l = 0; l < 32; ++l) {
        const int rho = (l & 15) * 34 + r32 + (l >> 4); const int swz = (rho >> 1) & 7; LAS const unsigned char* xr = lds + L_X + rho * 128;
#pragma unroll
        for (int dq = 0; dq < 4; ++dq) {
            const bf16x8 a = *(const LAS bf16x8*)(xr + (((2 * dq + hi) ^ swz) << 4));
            const bf16x8 bw = *(const GAS bf16x8*)(wrow + l * 64 + dq * 16);
            acc = __builtin_amdgcn_mfma_f32_32x32x16_bf16(a, bw, acc, 0, 0, 0);
            const v4u pz = *(const LAS v4u*)(lds + L_POS + (l * 64 + dq * 16 + 8 * hi) * 2); const v4u bz = __builtin_bit_cast(v4u, bw);
#pragma unroll
            for (int j = 0; j < 4; ++j) c1p = fmaf(bflo(bz[j]), bflo(pz[j]), fmaf(bfhi(bz[j]), bfhi(pz[j]), c1p));
        }
    }
    { const int col = 32 * wave + r32; float c1; { auto rr = __builtin_amdgcn_permlane32_swap(__float_as_uint(c1p), __float_as_uint(c1p), false, false); c1 = __uint_as_float(rr[0]) + __uint_as_float(rr[1]); }
#pragma unroll
      for (int i = 0; i < 16; ++i) { const int n = (i & 3) + 8 * (i >> 2) + 4 * hi; *(LAS bf16*)(lds + L_G + n * G_LD + col * 2) = (bf16)f2bf(gelu_tanh(acc[i] + c1)); } }
    __syncthreads();
    if (wave < 2) {
        f32x16 o;
#pragma unroll
        for (int i = 0; i < 16; ++i) o[i] = 0.f;
        const bf16* w2 = (kv ? C.W2V : C.W2K) + (size_t)(32 * wave + r32) * CMPH + 8 * hi;
#pragma unroll 4
        for (int s = 0; s < 16; ++s) {
            const bf16x8 a = *(const LAS bf16x8*)(lds + L_G + r32 * G_LD + (16 * s + 8 * hi) * 2);
            const bf16x8 bw = *(const GAS bf16x8*)(w2 + 16 * s);
            o = __builtin_amdgcn_mfma_f32_32x32x16_bf16(a, bw, o, 0, 0, 0);
        }
        const int d = 32 * wave + r32;
        if (kv == 0) { bf16* dst = C.KCMP + ((size_t)(b * NKV + g) * NCP + n0) * HD + d;
#pragma unroll
            for (int i = 0; i < 16; ++i) { const int n = (i & 3) + 8 * (i >> 2) + 4 * hi; dst[(size_t)n * HD] = (n0 + n < NCMP) ? (bf16)f2bf(o[i]) : (bf16)0; } }
        else { bf16* dst = C.VCMPT + ((size_t)(b * NKV + g) * HD + d) * NCP + n0;
#pragma unroll
            for (int hf = 0; hf < 2; ++hf) { float v[8];
#pragma unroll
                for (int j = 0; j < 8; ++j) { const int i = 8 * hf + j; const int n = (i & 3) + 8 * (i >> 2) + 4 * hi; v[j] = (n0 + n < NCMP) ? o[i] : 0.f; }
                v4u w; w.x = pk2(v[0], v[1]); w.y = pk2(v[2], v[3]); w.z = pk2(v[4], v[5]); w.w = pk2(v[6], v[7]);
                *(GAS v4u*)(dst + 16 * hf + 8 * hi) = w; } }
    }
    __syncthreads();
}
}

namespace nsa {
using f32x16 = __attribute__((ext_vector_type(16))) float;
typedef float f32x2_t __attribute__((ext_vector_type(2))); typedef __bf16 bf16x2_t __attribute__((ext_vector_type(2)));
__device__ __forceinline__ unsigned cvtpk(float lo, float hi) { f32x2_t v = {lo, hi}; bf16x2_t b = __builtin_convertvector(v, bf16x2_t); return __builtin_bit_cast(unsigned, b); }
constexpr int L_KV = 0, L_IMP = 65536, IMP_LD = 132, L_OT = 65536  , L_SELM = 131072 + 1024, L_UNION = L_SELM + 1024, L_SSQ = L_UNION + 64, L_END = L_SSQ + 128;
constexpr int OUTS_LD = 520;
static_assert(L_END <= LDS_BYTES && L_IMP + 64 * IMP_LD * 4 <= L_OT + 65536 && L_OT + 65536 <= 131072 && 32 * OUTS_LD * 2 <= 65536, "nsa LDS map");

__device__ __forceinline__ float half_max(float m) { auto rr = __builtin_amdgcn_permlane32_swap(__float_as_uint(m), __float_as_uint(m), false, false); return fmaxf(__uint_as_float(rr[0]), __uint_as_float(rr[1])); }
__device__ __forceinline__ float half_sum(float m) { auto rr = __builtin_amdgcn_permlane32_swap(__float_as_uint(m), __float_as_uint(m), false, false); return __uint_as_float(rr[0]) + __uint_as_float(rr[1]); }

template <bool HASV> __device__ __forceinline__ void stage_dma(LAS unsigned char* kb, const bf16* k, int ks, const bf16* v, int vs, int wg, int lane) {
#pragma unroll
    for (int i = 0; i < 2; ++i) { const int row = 16 * wg + 8 * i + (lane >> 3), c8 = (lane & 7) ^ ((row >> 1) & 7);
        __builtin_amdgcn_global_load_lds((const GAS unsigned*)(k + (size_t)row * ks + c8 * 8), (LAS unsigned*)(kb + (16 * wg + 8 * i) * 128), 16, 0, 0);
        if (HASV) __builtin_amdgcn_global_load_lds((const GAS unsigned*)(v + (size_t)row * vs + c8 * 8), (LAS unsigned*)(kb + 8192 + (16 * wg + 8 * i) * 128), 16, 0, 0); }
}

template <bool DO_PV, bool DO_IMP, bool MASK>
__device__ __forceinline__ void step32(LAS const unsigned char* kb, int kt, const bf16x8 (&qf)[4], const int (&off)[4], float sl, float b0, int klo, int rng,
                                       float& m, float& l, f32x16 (&O)[2], int hi, LAS float* improw, int jb, float invl, bool impw) {
    f32x16 p;
#pragma unroll
    for (int i = 0; i < 16; ++i) p[i] = 0.f;
#pragma unroll
    for (int s = 0; s < 4; ++s) { const bf16x8 k0 = *(const LAS bf16x8*)(kb + kt * 4096 + off[s]); p = __builtin_amdgcn_mfma_f32_32x32x16_bf16(k0, qf[s], p, 0, 0, 0); }
    const float NEG = -INFINITY;
    float rm = NEG;
#pragma unroll
    for (int i = 0; i < 16; ++i) {
        const int c = (i & 3) + 8 * (i >> 2) + 32 * kt;
        float a = fmaf(sl, (float)c, p[i]);
        if (MASK) { if ((unsigned)(c + 4 * hi - klo) > (unsigned)rng) a = NEG; }
        p[i] = a; rm = fmaxf(rm, a);
    }
    const float sl4 = sl * (float)(4 * hi);
    rm = half_max(rm + sl4);
    const float mn = fmaxf(m, rm + b0);
    if (__any(mn > m)) {
        const float alpha = __builtin_amdgcn_exp2f(m - mn);
        l *= alpha;
        if (DO_PV) {
#pragma unroll
            for (int i = 0; i < 16; ++i) { O[0][i] *= alpha; O[1][i] *= alpha; }
        }
        m = mn;
    }
    const float mb = m - b0 - sl4;
    float ps0 = 0.f, ps1 = 0.f, ps2 = 0.f, ps3 = 0.f;
#pragma unroll
    for (int i = 0; i < 16; i += 4) { p[i] = __builtin_amdgcn_exp2f(p[i] - mb); p[i + 1] = __builtin_amdgcn_exp2f(p[i + 1] - mb); p[i + 2] = __builtin_amdgcn_exp2f(p[i + 2] - mb); p[i + 3] = __builtin_amdgcn_exp2f(p[i + 3] - mb);
        ps0 += p[i]; ps1 += p[i + 1]; ps2 += p[i + 2]; ps3 += p[i + 3]; }
    l += (ps0 + ps1) + (ps2 + ps3);
    if (DO_IMP) {
#pragma unroll
        for (int gq = 0; gq < 4; ++gq) {
            float bb = 0.5f * p[4 * gq + 3] * invl; float aa = (p[4 * gq] + p[4 * gq + 1] + p[4 * gq + 2]) * invl + bb;
            aa += __shfl_xor(aa, 1); aa += __shfl_xor(aa, 2); bb += __shfl_xor(bb, 1); bb += __shfl_xor(bb, 2);
            if (impw) { const int j = jb + 8 * kt + 2 * gq + hi; (void)__hip_atomic_fetch_add(improw + j, aa, __ATOMIC_RELAXED, __HIP_MEMORY_SCOPE_WORKGROUP); (void)__hip_atomic_fetch_add(improw + j + 1, bb, __ATOMIC_RELAXED, __HIP_MEMORY_SCOPE_WORKGROUP); }
        }
    }
    if (DO_PV) {
#pragma unroll
        for (int k2 = 0; k2 < 2; ++k2) {
            v4u pw;
#pragma unroll
            for (int j = 0; j < 4; ++j) pw[j] = cvtpk(p[8 * k2 + 2 * j], p[8 * k2 + 2 * j + 1]);
            const bf16x8 pf = __builtin_bit_cast(bf16x8, pw);
            const bf16x8 v0 = *(const LAS bf16x8*)(kb + 8192 + off[2 * kt + k2]);
            const bf16x8 v1 = *(const LAS bf16x8*)(kb + 8192 + 4096 + off[2 * kt + k2]);
            O[0] = __builtin_amdgcn_mfma_f32_32x32x16_bf16(v0, pf, O[0], 0, 0, 0);
            O[1] = __builtin_amdgcn_mfma_f32_32x32x16_bf16(v1, pf, O[1], 0, 0, 0);
        }
    }
}

enum { MODE_CMP1 = 0, MODE_CMP2 = 1, MODE_SEL = 2, MODE_WIN = 3 };
struct Ctx {
    const bf16 *Q, *KCMP, *VCMPT, *KSKW, *VST, *VWT; const float* GATE; const float* gn; bf16* MIXED;
};

__device__ __forceinline__ void nsa_unit(const Ctx& C, LAS unsigned char* lds, int b, int t0) {
    const int tid = threadIdx.x, lane = tid & 63, wave = __builtin_amdgcn_readfirstlane(tid >> 6), g = wave >> 2, gtid = tid & 255;
    const int r32 = lane & 31, hi = lane >> 5, qq = r32 >> 2, hq = r32 & 3;
    const int tq = 8 * (wave & 3) + qq, t = t0 + tq, hh = g * 4 + hq;
    const size_t mrow = (size_t)b * SEQ + t;
    const float slope2 = __builtin_amdgcn_exp2f(-(float)(hh + 1)) * LOG2E;
    LAS unsigned char* kv = lds + L_KV + g * 32768;
    LAS float* IMP = (LAS float*)(lds + L_IMP);
    LAS unsigned* SELM = (LAS unsigned*)(lds + L_SELM);
    LAS unsigned* UNI = (LAS unsigned*)(lds + L_UNION);
    LAS float* SSQ = (LAS float*)(lds + L_SSQ);
    int off[4];
#pragma unroll
    for (int s = 0; s < 4; ++s) off[s] = r32 * 128 + (((2 * s + hi) ^ ((r32 >> 1) & 7)) << 4);
    bf16x8 qf[4];
    { const bf16* qp = C.Q + mrow * 512 + hh * 64 + 8 * hi;
#pragma unroll
      for (int s = 0; s < 4; ++s) qf[s] = *(const GAS bf16x8*)(qp + 16 * s); }
    float gate[3];
#pragma unroll
    for (int br = 0; br < 3; ++br) gate[br] = C.GATE[mrow * 32 + hh * 3 + br];
    for (int i = tid; i < 64 * IMP_LD; i += 512) IMP[i] = 0.f;
    if (tid < 32) SSQ[tid] = 0.f;
    if (tid < 8) UNI[tid] = 0u;
    f32x16 OT[2];
    LAS float* otl = (LAS float*)(lds + L_OT) + tid;
    const int pair = g * 32 + tq;
    LAS float* improw = IMP + pair * IMP_LD;

    const bf16* kcb = C.KCMP + (size_t)(b * NKV + g) * NCP * HD; const bf16* vcb = C.VCMPT + (size_t)(b * NKV + g) * HD * NCP;
    const bf16* ksb = C.KSKW + (size_t)b * SEQ * 256 + g * 64; const bf16* kwb = ksb + 128;
    const bf16* vsb = C.VST + (size_t)(b * NKV + g) * 128 * 4096; const bf16* vwb = C.VWT + (size_t)(b * NKV + g) * 128 * 4096;
    const int nlim = (t >= 31) ? ((t - 31) >> 4) : -1;
    const int ntc = (t0 >> 10) + 1;
    const int jcur = t0 >> 6;
    unsigned selw[4] = {0u, 0u, 0u, 0u};
    float m_c = -1e30f, invl_c = 0.f;

#define NSA_BRANCH(MODE, TRIPS, NEXT_EXPR, KPTR, KSTR, VPTR, VSTR, MASKCODE, GATEV)                                                                  \
    {                                                                                                                                                \
        constexpr bool HASV = (MODE != MODE_CMP1);                                                                                                   \
        float m_ = (MODE == MODE_CMP2) ? m_c : -1e30f, l_ = 0.f; f32x16 O[2];                                                                        \
        _Pragma("unroll") for (int i = 0; i < 16; ++i) { O[0][i] = 0.f; O[1][i] = 0.f; }                                                             \
        const int trips_ = (TRIPS); int it_ = 0; int cur_ = -1, nxt_ = -1, ni_ = 0;                                                                  \
        if (trips_ > 0) { NEXT_EXPR; }                                                                                                               \
        if (nxt_ >= 0) { const int x = nxt_; stage_dma<HASV>(kv, KPTR, KSTR, VPTR, VSTR, wave & 3, lane); }                                           \
        asm volatile("s_waitcnt vmcnt(0)" ::: "memory"); __syncthreads();                                                                            \
        for (; it_ < trips_; ++it_) {                                                                                                                \
            cur_ = nxt_; ni_ = it_ + 1; if (ni_ < trips_) { NEXT_EXPR; } else nxt_ = -1;                                                             \
            if (nxt_ >= 0) { const int x = nxt_; stage_dma<HASV>(kv + (ni_ & 1) * 16384, KPTR, KSTR, VPTR, VSTR, wave & 3, lane); }                   \
            if (cur_ >= 0) { const int x = cur_; float sl, b0; int klo, khi; MASKCODE;                                                               \
                int rng = khi - klo; if (rng < 0) { klo = 1 << 20; rng = 0; }                                                                        \
                const bool skip = (MODE == MODE_SEL) && !__any(klo == 0);                                                                            \
                if (!skip) { const bool nm = __any(klo > 0 || rng < 63); LAS const unsigned char* kb_ = kv + (it_ & 1) * 16384;                      \
                    if (nm) { step32<HASV, MODE == MODE_CMP2, true>(kb_, 0, qf, off, sl, b0, klo, rng, m_, l_, O, hi, improw, 16 * x, invl_c, hq == 0);     \
                              step32<HASV, MODE == MODE_CMP2, true>(kb_, 1, qf, off, sl, b0, klo, rng, m_, l_, O, hi, improw, 16 * x, invl_c, hq == 0); }   \
                    else    { step32<HASV, MODE == MODE_CMP2, false>(kb_, 0, qf, off, sl, b0, klo, rng, m_, l_, O, hi, improw, 16 * x, invl_c, hq == 0);    \
                              step32<HASV, MODE == MODE_CMP2, false>(kb_, 1, qf, off, sl, b0, klo, rng, m_, l_, O, hi, improw, 16 * x, invl_c, hq == 0); } } } \
            asm volatile("s_waitcnt vmcnt(0)" ::: "memory"); __syncthreads();                                                                        \
        }                                                                                                                                            \
        const float lt = half_sum(l_);                                                                                                               \
        if (MODE == MODE_CMP1) { m_c = m_; invl_c = lt > 0.f ? 1.0f / lt : 0.f; }                                                                    \
        else { const float sc = (lt > 0.f) ? (GATEV) / lt : 0.f;                                                                                     \
            if (MODE == MODE_CMP2) { _Pragma("unroll") for (int i = 0; i < 16; ++i) { OT[0][i] = sc * O[0][i]; OT[1][i] = sc * O[1][i]; } }           \
            else if (MODE == MODE_SEL) { _Pragma("unroll") for (int i = 0; i < 16; ++i) { otl[i * 512] += sc * O[0][i]; otl[(16 + i) * 512] += sc * O[1][i]; } } \
            else { _Pragma("unroll") for (int i = 0; i < 16; ++i) { OT[0][i] = otl[i * 512] + sc * O[0][i]; OT[1][i] = otl[(16 + i) * 512] + sc * O[1][i]; } } } \
    }

#define CMP_MASK sl = 16.0f * slope2; b0 = slope2 * (float)(1024 * x + 31 - t); klo = 0; khi = min(63, nlim - 64 * x);
    NSA_BRANCH(MODE_CMP1, ntc, nxt_ = ntc - 1 - ni_, kcb + (size_t)x * 64 * 64, 64, vcb + x * 64, NCP, CMP_MASK, 0.f)
    NSA_BRANCH(MODE_CMP2, ntc, nxt_ = ntc - 1 - ni_, kcb + (size_t)x * 64 * 64, 64, vcb + x * 64, NCP, CMP_MASK, gate[0])
#undef CMP_MASK
    {
        const int pr = tid >> 3, sub = tid & 7; const int tqq = t0 + (pr & 31);
        const LAS float* row = IMP + pr * IMP_LD + sub * 16;
        unsigned key[16]; unsigned validm = 0u;
#pragma unroll
        for (int k = 0; k < 16; ++k) { const int j = sub * 16 + k; unsigned bits = __float_as_uint(row[k]);
            if (j == 0 || j == (tqq >> 6)) bits = 0x7f800000u;
            const bool valid = (64 * j <= tqq);
            key[k] = valid ? ((bits & 0xffffff80u) | (unsigned)(127 - j)) : 0u; validm |= (valid ? 1u : 0u) << k; }
        unsigned T = 0u;
        for (int bit = 30; bit >= 0; --bit) { const unsigned cand = T | (1u << bit); int cnt = 0;
#pragma unroll
            for (int k = 0; k < 16; ++k) cnt += (key[k] >= cand) ? 1 : 0;
            cnt += __shfl_xor(cnt, 1); cnt += __shfl_xor(cnt, 2); cnt += __shfl_xor(cnt, 4);
            if (cnt >= NTOP) T = cand; }
        unsigned sm = 0u;
#pragma unroll
        for (int k = 0; k < 16; ++k) sm |= ((key[k] >= T) ? 1u : 0u) << k;
        sm &= validm;
        ((LAS unsigned short*)SELM)[pr * 8 + sub] = (unsigned short)sm;
        (void)__hip_atomic_fetch_or(UNI + (pr >> 5) * 4 + (sub >> 1), sm << (16 * (sub & 1)), __ATOMIC_RELAXED, __HIP_MEMORY_SCOPE_WORKGROUP);
    }
    __syncthreads();
#pragma unroll
    for (int i = 0; i < 16; ++i) { otl[i * 512] = OT[0][i]; otl[(16 + i) * 512] = OT[1][i]; }
    {
#pragma unroll
        for (int w = 0; w < 4; ++w) selw[w] = SELM[pair * 4 + w];
        unsigned u0[4], u1[4];
#pragma unroll
        for (int w = 0; w < 4; ++w) { u0[w] = (unsigned)__builtin_amdgcn_readfirstlane(UNI[w]); u1[w] = (unsigned)__builtin_amdgcn_readfirstlane(UNI[4 + w]); }
        const int c0 = __builtin_popcount(u0[0]) + __builtin_popcount(u0[1]) + __builtin_popcount(u0[2]) + __builtin_popcount(u0[3]);
        const int c1 = __builtin_popcount(u1[0]) + __builtin_popcount(u1[1]) + __builtin_popcount(u1[2]) + __builtin_popcount(u1[3]);
        unsigned mw[4];
#pragma unroll
        for (int w = 0; w < 4; ++w) mw[w] = g ? u1[w] : u0[w];
#define SEL_NEXT { if (mw[3]) { const int bq = 31 - __builtin_clz(mw[3]); mw[3] &= ~(1u << bq); nxt_ = 96 + bq; } else if (mw[2]) { const int bq = 31 - __builtin_clz(mw[2]); mw[2] &= ~(1u << bq); nxt_ = 64 + bq; } \
            else if (mw[1]) { const int bq = 31 - __builtin_clz(mw[1]); mw[1] &= ~(1u << bq); nxt_ = 32 + bq; } else if (mw[0]) { const int bq = 31 - __builtin_clz(mw[0]); mw[0] &= ~(1u << bq); nxt_ = bq; } else nxt_ = -1; }
#define SEL_MASK sl = slope2; b0 = slope2 * (float)(64 * x - t); { const unsigned wsel = (x < 32) ? selw[0] : (x < 64) ? selw[1] : (x < 96) ? selw[2] : selw[3]; \
            const bool fl = (wsel >> (x & 31)) & 1u; klo = 0; khi = fl ? ((x == (t >> 6)) ? (t & 63) : 63) : -1; }
        NSA_BRANCH(MODE_SEL, max(c0, c1), SEL_NEXT, ksb + (size_t)x * 64 * 256, 256, vsb + (size_t)x * 4096, 64, SEL_MASK, gate[1])
#undef SEL_NEXT
#undef SEL_MASK
    }
    {
        const int nwin = min(9, jcur + 1);
#define WIN_MASK sl = slope2; b0 = slope2 * (float)(64 * x - t); klo = max(0, t - 511 - 64 * x); khi = min(63, t - 64 * x);
#ifdef NSA_XWIN
        NSA_BRANCH(MODE_SEL, nwin, nxt_ = jcur - ni_, kwb + (size_t)x * 64 * 256, 256, vwb + (size_t)x * 4096, 64, WIN_MASK, 0.f)
#endif
        NSA_BRANCH(MODE_WIN, nwin, nxt_ = jcur - ni_, kwb + (size_t)x * 64 * 256, 256, vwb + (size_t)x * 4096, 64, WIN_MASK, gate[2])
#undef WIN_MASK
    }
#undef NSA_BRANCH
    {
        float ss = 0.f;
#pragma unroll
        for (int i = 0; i < 16; ++i) ss += OT[0][i] * OT[0][i] + OT[1][i] * OT[1][i];
        ss += __shfl_xor(ss, 1); ss += __shfl_xor(ss, 2); ss = half_sum(ss);
        if (hq == 0 && hi == 0) (void)__hip_atomic_fetch_add(SSQ + tq, ss, __ATOMIC_RELAXED, __HIP_MEMORY_SCOPE_WORKGROUP);
        __syncthreads();
        const float r = 1.0f / sqrtf(SSQ[tq] * (1.0f / 512.0f) + EPS);
        LAS bf16* outs = (LAS bf16*)(lds + L_KV);
#pragma unroll
        for (int d0 = 0; d0 < 2; ++d0)
#pragma unroll
            for (int gq = 0; gq < 4; ++gq) { v2u w; w.x = cvtpk(OT[d0][4 * gq] * r, OT[d0][4 * gq + 1] * r); w.y = cvtpk(OT[d0][4 * gq + 2] * r, OT[d0][4 * gq + 3] * r);
                *(LAS v2u*)(outs + tq * OUTS_LD + hh * 64 + 32 * d0 + 8 * gq + 4 * hi) = w; }
        __syncthreads();
#pragma unroll
        for (int i = 0; i < 4; ++i) { const int id = tid + 512 * i, row = id >> 6, c = id & 63;
            const v4u v = *(const LAS v4u*)(outs + row * OUTS_LD + 8 * c); const f32x4 g0 = *(const GAS f32x4*)(C.gn + 8 * c), g1 = *(const GAS f32x4*)(C.gn + 8 * c + 4);
            v4u o; o.x = pk2(bflo(v.x) * g0[0], bfhi(v.x) * g0[1]); o.y = pk2(bflo(v.y) * g0[2], bfhi(v.y) * g0[3]); o.z = pk2(bflo(v.z) * g1[0], bfhi(v.z) * g1[1]); o.w = pk2(bflo(v.w) * g1[2], bfhi(v.w) * g1[3]);
            *(GAS v4u*)(C.MIXED + ((size_t)b * SEQ + t0 + row) * 1024 + 512 + 8 * c) = o; }
        __syncthreads();
    }
}
__device__ __forceinline__ void nsa_phase(const Ctx& C, LAS unsigned char* lds, int vcu, int G) {
    constexpr int NU = BATCH * (SEQ / 32);
    if (G == 256) { for (int i = 0; i < 2; ++i) { const int u = i ? (NU - 1 - vcu) : vcu; nsa_unit(C, lds, u >> 8, (u & 255) * 32); } }
    else for (int u = vcu; u < NU; u += G) nsa_unit(C, lds, u >> 8, (u & 255) * 32);
}
}

#ifndef MK_FUSED
#define MK_FUSED 0
#endif
#ifndef MK_SLOW_CMP
#define MK_SLOW_CMP 1
#endif
#ifndef MK_SLOW_NSA
#define MK_SLOW_NSA 1
#endif
#ifndef MK_REP
#define MK_REP -1
#endif
constexpr int N_PHASES = 8;
struct Args { const float* in[18]; float* out; unsigned char* ws; int ph_lo, ph_hi; };
__global__ void __launch_bounds__(NWAVES * 64, 2) mega_fwd(Args args) {
    extern __shared__ __attribute__((aligned(16))) unsigned char lds[];
    Frame F;
    F.lds = (LAS unsigned char*)lds;
    F.MISC = (volatile LAS unsigned*)(F.lds + MISC_OFF);
    F.tid = threadIdx.x; F.lane = F.tid & 63; F.wave = __builtin_amdgcn_readfirstlane(F.tid >> 6);
    F.G = gridDim.x; { const int bx = blockIdx.x; F.vcu = (F.G % 8 == 0) ? (bx % 8) * (F.G / 8) + bx / 8 : bx; }
    F.ws = args.ws; F.out = args.out; F.ctl = (gu32*)(args.ws + WS_CTL);
#pragma unroll
    for (int i = 0; i < 18; ++i) F.in[i] = args.in[i];
    for (int u = F.tid; u < (LDS_BYTES - LDSCTL_OFF) / 4; u += NWAVES * 64) ((LAS unsigned*)(F.lds + LDSCTL_OFF))[u] = 0u;
    __syncthreads();
    XcdBarrier bar; bar.bar = (unsigned*)(F.ctl + CW_BAR); bar.x = 0; bar.st = nullptr;
    const int lo = args.ph_lo, hi = args.ph_hi;
    if (hi - lo > 1) bar = xcd_barrier_post((unsigned*)(F.ctl + CW_BAR), F.MISC + 8);
#define IN(k) (lo <= (k) && (k) < hi)
#define BOTH(k) (IN(k) && IN((k) + 1))
#define GRID_BAR() xcd_barrier(bar)
    unsigned char* ws = args.ws;
    pg8::bf16_t* XN = (pg8::bf16_t*)(ws + WS_XN);
    const int gw = F.vcu * NWAVES + F.wave, NGW = F.G * NWAVES;

#ifndef MK_P3_ONLY
    if (IN(0)) { p0_prologue(F); if (BOTH(0)) GRID_BAR(); }

    if (IN(1)) {
        pg8::Gemm g{XN, (const pg8::bf16_t*)(ws + WS_WIN), M, NPROJ, DM};
        { pg8::OrderInA S; S.S.init(M, 11 * 256, F.G, (int)blockIdx.x);
          pg8::EpiInProj E{(pg8::bf16_t*)(ws + WS_CB), (pg8::bf16_t*)(ws + WS_U), (pg8::bf16_t*)(ws + WS_Q), (pg8::bf16_t*)(ws + WS_KCVC), (pg8::bf16_t*)(ws + WS_KSKW), (float*)(ws + WS_GATE)};
          pg8::gemm_phase<pg8::EpiInProj, pg8::OrderInA, true, true, false>(F.lds + RING_OFF, g, S, E); }
        { pg8::OrderInB S{F.G, (int)blockIdx.x};
          pg8::EpiVT E{(pg8::bf16_t*)(ws + WS_VST), (pg8::bf16_t*)(ws + WS_VWT)};
          pg8::gemm_phase<pg8::EpiVT, pg8::OrderInB, false, true, true>(F.lds + RING_OFF, g, S, E); }
        if (BOTH(1)) GRID_BAR();
    }

    if (IN(2)) {
#if MK_SLOW_CMP
        late_weights(F, gw, NGW);
        for (int m = gw; m < M; m += NGW) conv_token((const bf16*)(ws + WS_CB), (const bf16*)(ws + WS_U), F.in[3], F.in[10], (bf16*)(ws + WS_MIXED), m, F.lane);
#else
        const cmp::Ctx CC{(const bf16*)(ws + WS_KCVC), (const bf16*)(ws + WS_CW1K), (const bf16*)(ws + WS_CW1V), (const bf16*)(ws + WS_CW2K), (const bf16*)(ws + WS_CW2V), F.in[4], F.in[7],
                          (bf16*)(ws + WS_KCMP), (bf16*)(ws + WS_VCMPT)};
        if (F.G == 256) {
            const int bx = blockIdx.x, idx = (bx >> 4) * 8 + (bx & 7);
            if (((bx >> 3) & 1) == 0) cmp::cmp_unit(CC, F.lds + RING_OFF, idx);
            else { late_weights(F, idx * NWAVES + F.wave, 128 * NWAVES);
                for (int m = idx * NWAVES + F.wave; m < M; m += 128 * NWAVES) conv_token((const bf16*)(ws + WS_CB), (const bf16*)(ws + WS_U), F.in[3], F.in[10], (bf16*)(ws + WS_MIXED), m, F.lane); }
        } else {
            late_weights(F, gw, NGW); __syncthreads();
            for (int u = F.vcu; u < 128; u += F.G) cmp::cmp_unit(CC, F.lds + RING_OFF, u);
            for (int m = gw; m < M; m += NGW) conv_token((const bf16*)(ws + WS_CB), (const bf16*)(ws + WS_U), F.in[3], F.in[10], (bf16*)(ws + WS_MIXED), m, F.lane);
        }
#endif
        if (BOTH(2)) GRID_BAR();
    }

#endif
    if (IN(3)) {
#if !MK_SLOW_NSA
        const nsa::Ctx C{(const bf16*)(ws + WS_Q), (const bf16*)(ws + WS_KCMP), (const bf16*)(ws + WS_VCMPT), (const bf16*)(ws + WS_KSKW), (const bf16*)(ws + WS_VST), (const bf16*)(ws + WS_VWT),
                         (const float*)(ws + WS_GATE), F.in[11], (bf16*)(ws + WS_MIXED)};
        nsa::nsa_phase(C, F.lds + RING_OFF, F.vcu, F.G);
#endif
        if (BOTH(3)) GRID_BAR();
    }

#ifndef MK_P3_ONLY
    if (IN(4)) {
        pg8::Gemm g{(const pg8::bf16_t*)(ws + WS_MIXED), (const pg8::bf16_t*)(ws + WS_WOUT), M, DM, DM};
        pg8::StaticOrder S; S.init(M, DM, F.G, (int)blockIdx.x);
        pg8::EpiOutProj E{F.in[0], F.out, XN, (float*)(ws + WS_SSQ1)};
        pg8::gemm_phase<pg8::EpiOutProj, pg8::StaticOrder, false, true, false>(F.lds + RING_OFF, g, S, E);
        if (BOTH(4)) GRID_BAR();
    }

    if (IN(5)) {
        pg8::Gemm g{XN, (const pg8::bf16_t*)(ws + WS_WGU), M, 2 * DFF, DM};
        pg8::StaticOrder S; S.init(M, 2 * DFF, F.G, (int)blockIdx.x);
        pg8::EpiSwiGLU E{(const float*)(ws + WS_SSQ1), (pg8::bf16_t*)(ws + WS_ACT)};
        pg8::gemm_phase<pg8::EpiSwiGLU, pg8::StaticOrder, true, true, false>(F.lds + RING_OFF, g, S, E);
        if (BOTH(5)) GRID_BAR();
    }

    if (IN(6)) {
        pg8::Gemm g{(const pg8::bf16_t*)(ws + WS_ACT), (const pg8::bf16_t*)(ws + WS_WDN), M, DM, DFF};
        pg8::StaticOrder S; S.init(M, DM, F.G, (int)blockIdx.x);
        pg8::EpiDown E{F.out, (float*)(ws + WS_SSQ2)};
        pg8::gemm_phase<pg8::EpiDown, pg8::StaticOrder, false, true, false>(F.lds + RING_OFF, g, S, E);
        if (BOTH(6)) GRID_BAR();
    }

    if (IN(7)) {
        for (int m = gw; m < M; m += NGW) final_row(F.out, (const float*)(ws + WS_SSQ2), F.in[17], F.out, m, F.lane);
    }
#endif
#undef IN
#undef BOTH
#undef GRID_BAR
}

extern "C" void kernel_launch(void* const* d_in, const int* in_sizes, int n_in, void* d_out, int out_size, void* d_ws, size_t ws_size, hipStream_t stream) {
    static int grid = 0;
    if (grid == 0) {
        if (n_in != 18 || in_sizes[0] != M * DM || out_size != M * DM || ws_size < WS_END) { fprintf(stderr, "kernel_launch: unexpected shapes (n_in %d, in0 %d, out %d, ws %zu); nothing launched\n", n_in, n_in > 0 ? in_sizes[0] : -1, out_size, ws_size); grid = -1; return; }
        int dev = 0, cus = 0, per_cu = 0;
        if (hipGetDevice(&dev) != hipSuccess || hipDeviceGetAttribute(&cus, hipDeviceAttributeMultiprocessorCount, dev) != hipSuccess) { grid = -1; return; }
        if (hipFuncSetAttribute((const void*)mega_fwd, hipFuncAttributeMaxDynamicSharedMemorySize, LDS_BYTES) != hipSuccess) { fprintf(stderr, "kernel_launch: hipFuncSetAttribute failed\n"); grid = -1; return; }
        if (hipOccupancyMaxActiveBlocksPerMultiprocessor(&per_cu, (const void*)mega_fwd, NWAVES * 64, LDS_BYTES) != hipSuccess || per_cu < 1)
            fprintf(stderr, "kernel_launch: note: occupancy query reports %d workgroups per CU\n", per_cu);
        (void)hipGetLastError();
        grid = cus;
    }
    if (grid < 0) return;
    unsigned char* ws = (unsigned char*)d_ws;
    if (hipMemsetAsync(ws + WS_CTL, 0, CTL_ZERO_BYTES, stream) != hipSuccess) { fprintf(stderr, "kernel_launch: memset failed\n"); return; }
    Args a{};
    for (int i = 0; i < 18; ++i) a.in[i] = (const float*)d_in[i];
    a.out = (float*)d_out; a.ws = ws;
#define LAUNCH(lo_, hi_) do { a.ph_lo = (lo_); a.ph_hi = (hi_); hipLaunchKernelGGL(mega_fwd, dim3(grid), dim3(NWAVES * 64), LDS_BYTES, stream, a); } while (0)
#if MK_FUSED
    LAUNCH(0, N_PHASES);
#else
    LAUNCH(0, 1); LAUNCH(1, 2); LAUNCH(2, 3);
#if MK_SLOW_CMP
    {
        const int R = BATCH * NCMP * NKV;
        float* ACMP = (float*)(ws + WS_ACMP); float* HID = (float*)(ws + WS_HID); float* COUT = (float*)(ws + WS_COUT);
        for (int kv = 0; kv < 2; ++kv) {
            slow::cmp_gather_k<<<(unsigned)(((size_t)R * CMPK + 255) / 256), 256, 0, stream>>>((const bf16*)(ws + WS_KCVC), kv ? 128 : 0, (const float*)d_in[kv ? 7 : 4], ACMP);
            slow::gemm_f32<1><<<dim3(CMPH / 64, (R + 63) / 64), 256, 0, stream>>>(ACMP, CMPK, (const float*)d_in[kv ? 8 : 5], CMPH, HID, CMPH, R, CMPH, CMPK);
            slow::gemm_f32<0><<<dim3(1, (R + 63) / 64), 256, 0, stream>>>(HID, CMPH, (const float*)d_in[kv ? 9 : 6], HD, COUT, HD, R, HD, CMPH);
            slow::cmp_pack_k<<<(BATCH * NKV * NCP * HD + 255) / 256, 256, 0, stream>>>(COUT, kv, (bf16*)(ws + (kv ? WS_VCMPT : WS_KCMP)));
        }
    }
#endif
#if MK_SLOW_NSA
    slow::nsa_k<<<M * NKV, 256, 0, stream>>>((const bf16*)(ws + WS_Q), (const bf16*)(ws + WS_KCMP), (const bf16*)(ws + WS_VCMPT), (const bf16*)(ws + WS_KSKW), (const bf16*)(ws + WS_VST), (const bf16*)(ws + WS_VWT),
                                            (const float*)(ws + WS_GATE), (float*)(ws + WS_NSAOUT));
    slow::rms_bf16_k<<<M / 4, 256, 0, stream>>>((const float*)(ws + WS_NSAOUT), (const float*)d_in[11], (bf16*)(ws + WS_MIXED));
#else
    LAUNCH(3, 4);
#endif
    LAUNCH(4, 5); LAUNCH(5, 6); LAUNCH(6, 7); LAUNCH(7, 8);
#endif
#ifdef MK_EXTRA_LO
    LAUNCH(MK_EXTRA_LO, MK_EXTRA_HI);
#endif
    const hipError_t le = hipPeekAtLastError();
    if (le != hipSuccess) fprintf(stderr, "kernel_launch: launch failed: %s\n", hipGetErrorName(le));
}
```
